# Optimizing an MI355X kernel written in HIP

```python
import jax, jax.numpy as jnp
from jax import lax
import numpy as np

D_MODEL = 1024
BATCH = 2
SEQ = 8192
DEPTH = 1
DEC_BATCH = 8
DEC_SEQ = 2048
PAST_LEN = 128

PLE_DIM = 256
MIX_W = D_MODEL
RET_HEADS = 4
MLSTM_HEADS = 4
RET_W = MIX_W // 2
MLSTM_W = MIX_W - RET_W
RET_HD = RET_W // RET_HEADS
MLSTM_HD = MLSTM_W // MLSTM_HEADS
N_GATE_COLS = 4 * MLSTM_HEADS
IN_COLS = 4 * RET_W + 4 * MLSTM_W + N_GATE_COLS
D_FF = ((8 * D_MODEL // 3) + 127) // 128 * 128
CHUNK = 128
CONV_W = 3
ROPE_BASE = 10000.0
RMS_EPS = 1e-6
HN_EPS = 1e-5

kernel_name = 'bidir_retention_mlstm_hybrid'


def rmsnorm(x, w):
    xf = x.astype(jnp.float32)
    y = xf * lax.rsqrt(jnp.mean(xf * xf, axis=-1, keepdims=True) + RMS_EPS)
    return (y * w.astype(jnp.float32)).astype(x.dtype)


def head_layernorm(x, w, n_heads):
    B, S, C = x.shape
    xh = x.reshape(B, S, n_heads, C // n_heads)
    mu = jnp.mean(xh, axis=-1, keepdims=True)
    var = jnp.mean(jnp.square(xh - mu), axis=-1, keepdims=True)
    y = ((xh - mu) * lax.rsqrt(var + HN_EPS)).reshape(B, S, C)
    return y * w.astype(jnp.float32)


def dwconv_centred(x, w, b):
    xp = jnp.pad(x, ((0, 0), (1, 1), (0, 0)))
    return xp[:, :-2] * w[0] + xp[:, 1:-1] * w[1] + xp[:, 2:] * w[2] + b


def rotary(x):
    S, d = x.shape[1], x.shape[3]
    inv = ROPE_BASE ** (-jnp.arange(0, d, 2, dtype=jnp.float32) / d)
    ang = jnp.arange(S, dtype=jnp.float32)[:, None] * inv[None, :]
    cos = jnp.concatenate([jnp.cos(ang), jnp.cos(ang)], axis=-1)[None, :, None, :]
    sin = jnp.concatenate([jnp.sin(ang), jnp.sin(ang)], axis=-1)[None, :, None, :]
    x1, x2 = x[..., : d // 2], x[..., d // 2:]
    rot = jnp.concatenate([-x2, x1], axis=-1)
    return x * cos + rot * sin


def to_heads(t, n_heads):
    B, S, C = t.shape
    return t.reshape(B, S, n_heads, C // n_heads).transpose(0, 2, 1, 3)


def from_heads(t):
    B, H, S, d = t.shape
    return t.transpose(0, 2, 1, 3).reshape(B, S, H * d)


def flip_seq(t):
    return jnp.flip(t, axis=2)


def retention_dir(q, k, v, log_gamma, strict):
    B, H, S, d = q.shape
    nc, L = S // CHUNK, CHUNK
    qc = q.reshape(B, H, nc, L, d)
    kc = k.reshape(B, H, nc, L, d)
    vc = v.reshape(B, H, nc, L, v.shape[-1])
    idx = jnp.arange(L, dtype=jnp.float32)
    diff = idx[:, None] - idx[None, :]
    mask = (diff > 0) if strict else (diff >= 0)
    decay_in = jnp.where(mask[None], jnp.exp(jnp.maximum(diff, 0.0)[None] * log_gamma[:, None, None]), 0.0)
    scores = jnp.einsum('bhcid,bhcjd->bhcij', qc, kc) * decay_in[:, None]
    inner = jnp.einsum('bhcij,bhcje->bhcie', scores, vc)
    k_decay = jnp.exp((L - 1 - idx)[None, :] * log_gamma[:, None])
    upd = jnp.einsum('bhcjd,bhcje->cbhde', kc * k_decay[:, None, :, None], vc)
    chunk_decay = jnp.exp(L * log_gamma)[:, None, None]

    def step(state, u):
        return chunk_decay * state + u, state

    _, s_prev = lax.scan(step, jnp.zeros(upd.shape[1:], jnp.float32), upd)
    q_decay = jnp.exp((idx + 1.0)[None, :] * log_gamma[:, None])
    cross = jnp.einsum('bhcid,cbhde->bhcie', qc * q_decay[:, None, :, None], s_prev)
    return (inner + cross).reshape(B, H, S, vc.shape[-1])


def mlstm_dir(q, k, v, ig, lf):
    B, H, S, d = q.shape
    nc, L = S // CHUNK, CHUNK

    def to_chunks(t):
        return jnp.moveaxis(t.reshape((B, H, nc, L) + t.shape[3:]), 2, 0)

    xs = (to_chunks(q), to_chunks(k), to_chunks(v), to_chunks(ig), to_chunks(lf))
    causal = jnp.tril(jnp.ones((L, L), dtype=bool))

    def step(carry, inp):
        C, n, m = carry
        qc, kc, vc, igc, lfc = inp
        a = jnp.cumsum(lfc, axis=-1)
        log_d = jnp.where(causal, a[..., :, None] - a[..., None, :] + igc[..., None, :], -jnp.inf)
        m_inter = a + m[..., None]
        m_t = jnp.maximum(m_inter, jnp.max(log_d, axis=-1))
        s = jnp.einsum('bhid,bhjd->bhij', qc, kc) * jnp.exp(log_d - m_t[..., None])
        w_inter = jnp.exp(m_inter - m_t)
        num = w_inter[..., None] * jnp.einsum('bhid,bhde->bhie', qc, C) + jnp.einsum('bhij,bhje->bhie', s, vc)
        den = w_inter * jnp.einsum('bhid,bhd->bhi', qc, n) + jnp.sum(s, axis=-1)
        h = num / jnp.maximum(jnp.abs(den), jnp.exp(-m_t))[..., None]
        a_last = a[..., -1]
        log_w = a_last[..., None] - a + igc
        m_new = jnp.maximum(a_last + m, jnp.max(log_w, axis=-1))
        decay = jnp.exp(a_last + m - m_new)
        kw = kc * jnp.exp(log_w - m_new[..., None])[..., None]
        C_new = decay[..., None, None] * C + jnp.einsum('bhjd,bhje->bhde', kw, vc)
        n_new = decay[..., None] * n + jnp.sum(kw, axis=-2)
        return (C_new, n_new, m_new), h

    init = (jnp.zeros((B, H, d, v.shape[-1]), jnp.float32), jnp.zeros((B, H, d), jnp.float32), jnp.zeros((B, H), jnp.float32))
    _, hs = lax.scan(step, init, xs)
    return jnp.moveaxis(hs, 0, 2).reshape(B, H, S, v.shape[-1])


def token_mixers(a, w_in, mlstm_conv_w, mlstm_conv_b, mlstm_gate_b, ret_decay_logit, ret_gn_w, mlstm_gn_w, w_out):
    B, S, _ = a.shape
    f32 = jnp.float32
    proj = (a @ w_in).astype(f32)
    splits = [RET_W, 2 * RET_W, 3 * RET_W, 4 * RET_W, 4 * RET_W + 2 * MLSTM_W, 4 * RET_W + 3 * MLSTM_W, 4 * RET_W + 4 * MLSTM_W]
    rq, rk, rv, rg, mqk, mv, mo, mgates = jnp.split(proj, splits, axis=-1)

    rq = rotary(rq.reshape(B, S, RET_HEADS, RET_HD)).transpose(0, 2, 1, 3) * (RET_HD ** -0.5)
    rk = rotary(rk.reshape(B, S, RET_HEADS, RET_HD)).transpose(0, 2, 1, 3)
    rv = to_heads(rv, RET_HEADS)
    lg = jax.nn.log_sigmoid(ret_decay_logit.astype(f32))
    ret = retention_dir(rq, rk, rv, lg[0], False) + flip_seq(retention_dir(flip_seq(rq), flip_seq(rk), flip_seq(rv), lg[1], True))
    ret = head_layernorm(from_heads(ret), ret_gn_w, RET_HEADS) * jax.nn.silu(rg)

    mqk = jax.nn.silu(dwconv_centred(mqk, mlstm_conv_w.astype(f32), mlstm_conv_b.astype(f32)))
    mq, mk = jnp.split(mqk, 2, axis=-1)
    mq = to_heads(mq, MLSTM_HEADS) * (MLSTM_HD ** -0.5)
    mk = to_heads(mk, MLSTM_HEADS)
    mv = to_heads(mv, MLSTM_HEADS)
    g = (mgates.reshape(B, S, 4, MLSTM_HEADS) + mlstm_gate_b.astype(f32)).transpose(2, 0, 3, 1)
    ig_f, ig_b = g[0], g[1]
    lf_f, lf_b = jax.nn.log_sigmoid(g[2]), jax.nn.log_sigmoid(g[3])
    mh = mlstm_dir(mq, mk, mv, ig_f, lf_f) + flip_seq(mlstm_dir(flip_seq(mq), flip_seq(mk), flip_seq(mv), flip_seq(ig_b), flip_seq(lf_b)))
    mh = head_layernorm(from_heads(mh), mlstm_gn_w, MLSTM_HEADS) * jax.nn.sigmoid(mo)

    mixed = jnp.concatenate([ret, mh], axis=-1).astype(a.dtype)
    return mixed @ w_out


def trunk(h, p, params):
    (norm_mix_w, w_in, mlstm_conv_w, mlstm_conv_b, mlstm_gate_b, ret_decay_logit, ret_gn_w, mlstm_gn_w, w_out,
     norm_ffn_w, ffn_w_gate, ffn_w_up, ffn_conv_w, ffn_conv_b, ffn_w_down,
     ple_w_proj, ple_norm_w, ple_w_gate, ple_gate_b, final_norm_w) = params
    for l in range(DEPTH):
        a = rmsnorm(h, norm_mix_w[l])
        h = h + token_mixers(a, w_in[l], mlstm_conv_w[l], mlstm_conv_b[l], mlstm_gate_b[l], ret_decay_logit[l], ret_gn_w[l], mlstm_gn_w[l], w_out[l])
        f = rmsnorm(h, norm_ffn_w[l])
        u = dwconv_centred(f @ ffn_w_gate[l], ffn_conv_w[l], ffn_conv_b[l])
        h = h + (jax.nn.gelu(u, approximate=False) * (f @ ffn_w_up[l])) @ ffn_w_down[l]
        gate = jax.nn.sigmoid(rmsnorm(h, ple_norm_w[l]) @ ple_w_gate[l] + ple_gate_b[l])
        h = h + (p[l] @ ple_w_proj[l]) * gate
    return rmsnorm(h, final_norm_w)


def setup_inputs(seed: int = 0) -> dict:
    key = jax.random.key(seed)
    ks = jax.random.split(key, 24)
    nrm = jax.random.normal
    f32 = jnp.float32
    gam = 1.0 - 2.0 ** (-5.0 - np.arange(RET_HEADS, dtype=np.float32))
    logit0 = jnp.asarray(np.log(gam / (1.0 - gam)), dtype=f32)
    i_bias = 0.1 * nrm(ks[6], (DEPTH, 2, MLSTM_HEADS), f32)
    f_bias = jnp.linspace(3.0, 6.0, MLSTM_HEADS, dtype=f32) + 0.1 * nrm(ks[7], (DEPTH, 2, MLSTM_HEADS), f32)
    return {
        'x_prompt': nrm(ks[0], (BATCH, SEQ, D_MODEL), f32),
        'x_sample': nrm(ks[1], (DEC_BATCH, DEC_SEQ, D_MODEL), f32),
        'p_prompt': nrm(ks[2], (DEPTH, BATCH, SEQ, PLE_DIM), f32),
        'p_sample': nrm(ks[3], (DEPTH, DEC_BATCH, DEC_SEQ, PLE_DIM), f32),
        'norm_mix_w': 1.0 + 0.02 * nrm(ks[4], (DEPTH, D_MODEL), f32),
        'w_in': nrm(ks[5], (DEPTH, D_MODEL, IN_COLS), f32) * D_MODEL ** -0.5,
        'mlstm_conv_w': nrm(ks[8], (DEPTH, CONV_W, 2 * MLSTM_W), f32) * CONV_W ** -0.5,
        'mlstm_conv_b': 0.02 * nrm(ks[9], (DEPTH, 2 * MLSTM_W), f32),
        'mlstm_gate_b': jnp.concatenate([i_bias, f_bias], axis=1),
        'ret_decay_logit': logit0 + 0.05 * nrm(ks[10], (DEPTH, 2, RET_HEADS), f32),
        'ret_gn_w': 1.0 + 0.02 * nrm(ks[11], (DEPTH, RET_W), f32),
        'mlstm_gn_w': 1.0 + 0.02 * nrm(ks[12], (DEPTH, MLSTM_W), f32),
        'w_out': nrm(ks[13], (DEPTH, MIX_W, D_MODEL), f32) * MIX_W ** -0.5,
        'norm_ffn_w': 1.0 + 0.02 * nrm(ks[14], (DEPTH, D_MODEL), f32),
        'ffn_w_gate': nrm(ks[15], (DEPTH, D_MODEL, D_FF), f32) * D_MODEL ** -0.5,
        'ffn_w_up': nrm(ks[16], (DEPTH, D_MODEL, D_FF), f32) * D_MODEL ** -0.5,
        'ffn_conv_w': nrm(ks[17], (DEPTH, CONV_W, D_FF), f32) * CONV_W ** -0.5,
        'ffn_conv_b': 0.02 * nrm(ks[18], (DEPTH, D_FF), f32),
        'ffn_w_down': nrm(ks[19], (DEPTH, D_FF, D_MODEL), f32) * D_FF ** -0.5,
        'ple_w_proj': nrm(ks[20], (DEPTH, PLE_DIM, D_MODEL), f32) * PLE_DIM ** -0.5,
        'ple_norm_w': 1.0 + 0.02 * nrm(ks[21], (DEPTH, D_MODEL), f32),
        'ple_w_gate': nrm(ks[22], (DEPTH, D_MODEL, D_MODEL), f32) * D_MODEL ** -0.5,
        'ple_gate_b': 0.02 * nrm(ks[23], (DEPTH, D_MODEL), f32),
        'final_norm_w': 1.0 + 0.02 * nrm(jax.random.fold_in(key, 99), (D_MODEL,), f32),
    }


def reference(x_prompt, x_sample, p_prompt, p_sample, norm_mix_w, w_in, mlstm_conv_w, mlstm_conv_b, mlstm_gate_b,
              ret_decay_logit, ret_gn_w, mlstm_gn_w, w_out, norm_ffn_w, ffn_w_gate, ffn_w_up, ffn_conv_w, ffn_conv_b,
              ffn_w_down, ple_w_proj, ple_norm_w, ple_w_gate, ple_gate_b, final_norm_w):
    params = (norm_mix_w, w_in, mlstm_conv_w, mlstm_conv_b, mlstm_gate_b, ret_decay_logit, ret_gn_w, mlstm_gn_w, w_out,
              norm_ffn_w, ffn_w_gate, ffn_w_up, ffn_conv_w, ffn_conv_b, ffn_w_down,
              ple_w_proj, ple_norm_w, ple_w_gate, ple_gate_b, final_norm_w)
    y_prompt = trunk(x_prompt, p_prompt, params)
    y_sample = trunk(x_sample, p_sample, params)
    return (y_prompt, y_sample)
```

```cpp
#include <hip/hip_runtime.h>
#include <hip/hip_cooperative_groups.h>
#include <cstdio>
namespace cg = cooperative_groups;

#define LAS __attribute__((address_space(3)))
typedef unsigned short bf16_t;
typedef short bf16x8 __attribute__((ext_vector_type(8)));
typedef short s16x4 __attribute__((ext_vector_type(4)));
typedef float f32x4 __attribute__((ext_vector_type(4)));
typedef float f32x2 __attribute__((ext_vector_type(2)));
typedef unsigned u32x4 __attribute__((ext_vector_type(4)));
typedef unsigned u32x2 __attribute__((ext_vector_type(2)));

constexpr int NTOK = 32768, DM = 1024, NPROJ = 4096, INCOLS = 4112, DFF = 2816, PLE = 256, HALF_TOK = 16384;
constexpr size_t MiB = 1024ull * 1024ull;
constexpr size_t WS_PROJ = 0, WS_H1 = 0, WS_H1B = 128 * MiB, WS_PBF = 192 * MiB, WS_WPG = 208 * MiB, WS_WPP = 210 * MiB,
                 WS_RSS2 = 211 * MiB, WS_RSS3 = 211 * MiB + 128 * 1024, WS_GH = 212 * MiB, WS_BAR = 214 * MiB, WS_PPT = 216 * MiB;
constexpr size_t DO_ABF = 0, DO_MIXED = 0, DO_GATES = 64 * MiB, DO_ROPE = 66 * MiB, DO_TOT = 70 * MiB, DO_TOTS = 95 * MiB,
                 DO_RSS1 = 99 * MiB + 256 * 1024, DO_W1T = 100 * MiB, DO_WOT = 108 * MiB, DO_WGT = 110 * MiB, DO_WUT = 110 * MiB + 5632 * 1024,
                 DO_WDT = 121 * MiB, DO_G = 0, DO_GR = 88 * MiB, DO_UP = 93 * MiB + 512 * 1024, DO_HQ = 95 * MiB + 64 * 1024, DO_BAR = 99 * MiB + 512 * 1024;
constexpr int LDS_BYTES = 155648;
constexpr int NSLOT = 352;

struct Params { const float* in[24]; float* out; unsigned char* ws; int ph_lo, ph_hi; };

#define NTL(p) __builtin_nontemporal_load((const f32x4*)(p))
#define NTS(v, p) __builtin_nontemporal_store((v), (f32x4*)(p))
__device__ __forceinline__ unsigned cvt_pk_bf16(float lo, float hi) { unsigned r; asm volatile("v_cvt_pk_bf16_f32 %0, %1, %2" : "=v"(r) : "v"(lo), "v"(hi)); return r; }
__device__ __forceinline__ float bf_lo(unsigned w) { return __uint_as_float(w << 16); }
__device__ __forceinline__ float bf_hi(unsigned w) { return __uint_as_float(w & 0xffff0000u); }
__device__ __forceinline__ float sigmoidf_(float x) { return 1.0f / (1.0f + __expf(-x)); }
__device__ __forceinline__ float logsigmoidf_(float x) { return fminf(x, 0.0f) - log1pf(__expf(-fabsf(x))); }
__device__ __forceinline__ f32x2 gelu_pk(f32x2 v) {
    const f32x2 av = __builtin_elementwise_abs(v), d = av * 0.2316418882f + 1.0f;
    f32x2 t; t.x = __builtin_amdgcn_rcpf(d.x); t.y = __builtin_amdgcn_rcpf(d.y);
    f32x2 q = t * 0.5307027145f + (-0.7265760135f); q = q * t + 0.7107068705f; q = q * t + (-0.142248368f); q = q * t + 0.127414796f; q = q * t;
    const f32x2 s = (v * v) * (-0.72134752044f);
    f32x2 e; e.x = __builtin_amdgcn_exp2f(s.x); e.y = __builtin_amdgcn_exp2f(s.y);
    const f32x2 m = v * (q * e), r = v - m;
    f32x2 o; o.x = v.x < 0.f ? m.x : r.x; o.y = v.y < 0.f ? m.y : r.y; return o;
}
__device__ __forceinline__ const float* xrow(const Params& P, int t) { return t < HALF_TOK ? P.in[0] + (size_t)t * DM : P.in[1] + (size_t)(t - HALF_TOK) * DM; }
__device__ __forceinline__ const float* prow(const Params& P, int t) { return t < HALF_TOK ? P.in[2] + (size_t)t * PLE : P.in[3] + (size_t)(t - HALF_TOK) * PLE; }

namespace pg8 {
constexpr int BM = 256, BK = 64, HALF = 128, HTB = HALF * BK * 2, STAGE_BYTES = 8 * HTB, NXCD = 8, WGM = 8;
__device__ __forceinline__ int lds_byte(int r, int c) { const int st = (r >> 4) * 2 + (c >> 5), rr = r & 15, cc = c & 31, ob = rr * 64 + cc * 2; return st * 1024 + (ob ^ (((ob >> 9) & 1) << 5)); }
__device__ __forceinline__ void stage_rc(int b, int& R, int& C) { const int st = b / 1024, sb = b % 1024, swz = sb ^ (((sb >> 9) & 1) << 5); R = (st >> 1) * 16 + swz / 64; C = (st & 1) * 32 + (swz % 64) / 2; }
__device__ __forceinline__ int perm32(int rho) { const int n = rho >> 4, i = rho & 15; return 8 * (i >> 2) + 4 * n + (i & 3); }
struct Unit { int pm, pn, L; };
struct Gemm { const bf16_t* A; const bf16_t* Bt; int M, N, K; };
struct StaticOrder {
    int nM, nN, nwg, G, c, lo, hi;
    __device__ void init(int M, int N, int G_, int c_) { nM = M / BM; nN = N / BM; nwg = nM * nN; G = G_; c = c_; lo = 0; hi = nwg; }
    __device__ bool next(int i, Unit& u) const {
        const long L = (long)lo + (long)i * G + c; if (L >= hi) return false; u.L = (int)L;
        int wgid = (int)L; { const int q = nwg / NXCD, r = nwg % NXCD, xcd = wgid % NXCD, off = wgid / NXCD; wgid = (xcd < r ? xcd * (q + 1) : r * (q + 1) + (xcd - r) * q) + off; }
        const int nig = WGM * nN, gid = wgid / nig, fm = gid * WGM, gsz = (nM - fm) < WGM ? (nM - fm) : WGM;
        u.pm = fm + ((wgid % nig) % gsz); u.pn = (wgid % nig) / gsz; return true;
    }
};
template <class Epi>
__device__ __forceinline__ void gemm_phase(LAS unsigned char* lds, const Gemm g, const StaticOrder& S, const Epi& E) {
    int tid = threadIdx.x; asm volatile("" : "+v"(tid));
    const int wid = __builtin_amdgcn_readfirstlane(tid >> 6), lane = tid & 63, wr = wid >> 2, wc = wid & 3, fr = lane & 15, fq = lane >> 4;
    int K = g.K; asm volatile("" : "+s"(K));
    const int nt = K / BK;
    unsigned voffA[2], voffB[2];
#pragma unroll
    for (int i = 0; i < 2; ++i) { int R, C; stage_rc(tid * 16 + i * 8192, R, C); const int Rb = (R & ~31) + perm32(R & 31);
        voffA[i] = (unsigned)(R * K + C) * 2u; voffB[i] = (unsigned)(Rb * K + C) * 2u; }
    const size_t kstep = (size_t)(BK * 2);
    const size_t hstep = (size_t)HALF * K * 2;
    const size_t tstep = 2 * hstep;
    const unsigned ldsw = (unsigned)wid * 1024u;
    const int aoff = lds_byte(wr * 64 + fr, fq * 8), boff = lds_byte(wc * 32 + fr, fq * 8);
#define PG8_SA(b, h) (((b) * 2 + (h)) * HTB)
#define PG8_SB(b, h) ((4 + (b) * 2 + (h)) * HTB)
#define PG8_STAGE(bufoff, gbase, voff) do { _Pragma("unroll") for (int _i = 0; _i < 2; ++_i) \
        __builtin_amdgcn_global_load_lds((const unsigned*)((const char*)(gbase) + (voff)[_i]), (LAS unsigned*)(lds + (bufoff) + ldsw + _i * 8192), 16, 0, 0); } while (0)
#define PG8_LDA(dst, b, h) do { _Pragma("unroll") for (int m = 0; m < 4; ++m) _Pragma("unroll") for (int k = 0; k < 2; ++k) dst[m][k] = *(const LAS bf16x8*)(lds + PG8_SA(b, h) + aoff + m * 2048 + k * 1024); } while (0)
#define PG8_LDB(dst, b, h) do { _Pragma("unroll") for (int n = 0; n < 2; ++n) _Pragma("unroll") for (int k = 0; k < 2; ++k) dst[n][k] = *(const LAS bf16x8*)(lds + PG8_SB(b, h) + boff + n * 2048 + k * 1024); } while (0)
#define PG8_MMA(ai, bj, At, Bt) do { __builtin_amdgcn_s_setprio(1); _Pragma("unroll") for (int m = 0; m < 4; ++m) _Pragma("unroll") for (int n = 0; n < 2; ++n) _Pragma("unroll") for (int k = 0; k < 2; ++k) \
        acc[ai][bj][m][n] = __builtin_amdgcn_mfma_f32_16x16x32_bf16(Bt[n][k], At[m][k], acc[ai][bj][m][n], 0, 0, 0); __builtin_amdgcn_s_setprio(0); } while (0)
#define PG8_WAIT_V(n) asm volatile("s_waitcnt vmcnt(" #n ")" ::: "memory")
#define PG8_WAIT_L(n) asm volatile("s_waitcnt lgkmcnt(" #n ")" ::: "memory")
#define PG8_BAR __builtin_amdgcn_s_barrier()
#define PG8_SCHED __builtin_amdgcn_sched_barrier(0)
    Unit cur, nxt; int ui = 0;
    if (!S.next(0, cur)) return;
    f32x4 acc[2][2][4][2];
#pragma unroll
    for (int a = 0; a < 2; ++a)
#pragma unroll
        for (int b = 0; b < 2; ++b)
#pragma unroll
            for (int m = 0; m < 4; ++m)
#pragma unroll
                for (int n = 0; n < 2; ++n) acc[a][b][m][n] = (f32x4){0.f, 0.f, 0.f, 0.f};
    bf16x8 At[4][2], B0[2][2], B1[2][2];
    const char* cA = (const char*)g.A + (size_t)cur.pm * tstep; const char* cB = (const char*)g.Bt + (size_t)cur.pn * tstep;
    PG8_STAGE(PG8_SB(0, 0), cB, voffB); PG8_STAGE(PG8_SA(0, 0), cA, voffA); PG8_STAGE(PG8_SB(0, 1), cB + hstep, voffB); PG8_STAGE(PG8_SA(0, 1), cA + hstep, voffA);
    if (wr == 1) PG8_BAR;
    PG8_WAIT_V(4); PG8_BAR;
    PG8_STAGE(PG8_SB(1, 0), cB + kstep, voffB); PG8_STAGE(PG8_SA(1, 0), cA + kstep, voffA); PG8_STAGE(PG8_SB(1, 1), cB + hstep + kstep, voffB);
    PG8_WAIT_V(6); PG8_BAR;
    for (;;) {
        const bool has_next = S.next(ui + 1, nxt);
        const char* nA = has_next ? (const char*)g.A + (size_t)nxt.pm * tstep : cA; const char* nB = has_next ? (const char*)g.Bt + (size_t)nxt.pn * tstep : cB;
        for (int t = 0; t < nt; t += 2) {
            const bool last = (t == nt - 2);
            const char* a1 = cA + (size_t)(t + 1) * kstep;
            const char* a2 = last ? nA : cA + (size_t)(t + 2) * kstep; const char* b2 = last ? nB : cB + (size_t)(t + 2) * kstep;
            const char* a3 = a2 + kstep; const char* b3 = b2 + kstep;
            PG8_LDB(B0, 0, 0); PG8_SCHED; PG8_LDA(At, 0, 0); PG8_STAGE(PG8_SA(1, 1), a1 + hstep, voffA);
            PG8_WAIT_L(8); PG8_BAR; PG8_WAIT_L(0); PG8_MMA(0, 0, At, B0); PG8_BAR; PG8_SCHED;
            PG8_LDB(B1, 0, 1); PG8_STAGE(PG8_SB(0, 0), b2, voffB);
            PG8_BAR; PG8_WAIT_L(0); PG8_MMA(0, 1, At, B1); PG8_BAR;
            PG8_LDA(At, 0, 1); PG8_STAGE(PG8_SA(0, 0), a2, voffA);
            PG8_BAR; PG8_WAIT_L(0); PG8_MMA(1, 0, At, B0); PG8_BAR; PG8_SCHED;
            PG8_STAGE(PG8_SB(0, 1), b2 + hstep, voffB);
            PG8_WAIT_V(6); PG8_BAR; PG8_MMA(1, 1, At, B1); PG8_BAR;
            PG8_LDB(B0, 1, 0); PG8_SCHED; PG8_LDA(At, 1, 0); PG8_STAGE(PG8_SA(0, 1), a2 + hstep, voffA);
            PG8_WAIT_L(8); PG8_BAR; PG8_WAIT_L(0); PG8_MMA(0, 0, At, B0); PG8_BAR; PG8_SCHED;
            PG8_LDB(B1, 1, 1); PG8_STAGE(PG8_SB(1, 0), b3, voffB);
            PG8_BAR; PG8_WAIT_L(0); PG8_MMA(0, 1, At, B1); PG8_BAR;
            PG8_LDA(At, 1, 1); PG8_STAGE(PG8_SA(1, 0), a3, voffA);
            PG8_BAR; PG8_WAIT_L(0); PG8_MMA(1, 0, At, B0); PG8_BAR; PG8_SCHED;
            PG8_STAGE(PG8_SB(1, 1), b3 + hstep, voffB);
            PG8_WAIT_V(6); PG8_BAR; PG8_MMA(1, 1, At, B1); PG8_BAR;
        }
        E(acc, cur, wr, wc, fr, fq);
        if (!has_next) break;
#pragma unroll
        for (int a = 0; a < 2; ++a)
#pragma unroll
            for (int b = 0; b < 2; ++b)
#pragma unroll
                for (int m = 0; m < 4; ++m)
#pragma unroll
                    for (int n = 0; n < 2; ++n) acc[a][b][m][n] = (f32x4){0.f, 0.f, 0.f, 0.f};
        cur = nxt; cA = nA; cB = nB; ++ui;
    }
    PG8_WAIT_V(0);
    if (wr == 0) PG8_BAR;
    PG8_BAR;
#undef PG8_SA
#undef PG8_SB
#undef PG8_STAGE
#undef PG8_LDA
#undef PG8_LDB
#undef PG8_MMA
#undef PG8_WAIT_V
#undef PG8_WAIT_L
#undef PG8_BAR
#undef PG8_SCHED
}
}
using pg8::Unit;
typedef f32x4 AccT[2][2][4][2];

__device__ __forceinline__ unsigned dpp_prev(unsigned cur, unsigned below) {
    const int t = __builtin_amdgcn_update_dpp(0, (int)below, 0x121  , 0xf, 0xf, false);
    return (unsigned)__builtin_amdgcn_update_dpp(t, (int)cur, 0x111  , 0xf, 0xf, false);
}
__device__ __forceinline__ unsigned dpp_next(unsigned cur, unsigned above) {
    const int t = __builtin_amdgcn_update_dpp(0, (int)above, 0x12F  , 0xf, 0xf, false);
    return (unsigned)__builtin_amdgcn_update_dpp(t, (int)cur, 0x101  , 0xf, 0xf, false);
}
__device__ __forceinline__ float dppf_prev(float cur, float below) { return __uint_as_float(dpp_prev(__float_as_uint(cur), __float_as_uint(below))); }
__device__ __forceinline__ float dppf_next(float cur, float above) { return __uint_as_float(dpp_next(__float_as_uint(cur), __float_as_uint(above))); }
struct EpiProj {
    bf16_t* O; const f32x2* rope; bf16_t* HQ; const float* cw; const float* cb;
    __device__ __forceinline__ void operator()(AccT& acc, const Unit& u, int wr, int wc, int fr, int fq) const {
        asm volatile("" : "+v"(fr)); asm volatile("" : "+v"(fq));
        const int row0 = u.pm * 256 + wr * 64 + fr, col0 = u.pn * 256 + wc * 32 + 8 * fq;
        const bool rot = u.pn < 4, mqk = (u.pn >= 8 && u.pn < 12);
        const int i0 = 16 * wc + 4 * fq;
        if (mqk) {
            const int mc0 = col0 - 2048;
#pragma unroll
            for (int ai = 0; ai < 2; ++ai) { const int grp = u.pm * 4 + ai * 2 + wr;
#pragma unroll
                for (int bj = 0; bj < 2; ++bj) { const int mc = mc0 + bj * 128; const float mul = mc < 512 ? 0.08838834764831845f : 1.0f;
#pragma unroll
                    for (int n = 0; n < 2; ++n) {
                        const f32x4 w0 = *(const f32x4*)(cw + mc + 4 * n), w1 = *(const f32x4*)(cw + 1024 + mc + 4 * n), w2 = *(const f32x4*)(cw + 2048 + mc + 4 * n), b = *(const f32x4*)(cb + mc + 4 * n);
#pragma unroll
                        for (int m = 0; m < 4; ++m) { const int lr = m * 16 + fr; const f32x4 gc = acc[ai][bj][m][n]; f32x4 o;
#pragma unroll
                            for (int j = 0; j < 4; ++j) { const float gp = dppf_prev(gc[j], m > 0 ? acc[ai][bj][m - 1][n][j] : 0.f), gn = dppf_next(gc[j], m < 3 ? acc[ai][bj][m + 1][n][j] : 0.f);
                                const float uu = gp * w0[j] + gc[j] * w1[j] + gn * w2[j] + b[j]; o[j] = uu * sigmoidf_(uu) * mul; }
                            u32x2 w; w.x = cvt_pk_bf16(o[0], o[1]); w.y = cvt_pk_bf16(o[2], o[3]);
                            *(u32x2*)(O + (size_t)(grp * 64 + lr) * NPROJ + col0 + bj * 128 + 4 * n) = w;
                            if (m == 0 || m == 3) { if (lr < 2 || lr > 61) { u32x2 wg; wg.x = cvt_pk_bf16(gc[0], gc[1]); wg.y = cvt_pk_bf16(gc[2], gc[3]);
                                *(u32x2*)(HQ + (size_t)(grp * 4 + (lr < 2 ? lr : lr - 60)) * 1024 + mc + 4 * n) = wg; } } } } } }
            return; }
#pragma unroll
        for (int ai = 0; ai < 2; ++ai)
#pragma unroll
            for (int m = 0; m < 4; ++m) { const int row = row0 + ai * 128 + m * 16; bf16_t* rowp = O + (size_t)row * NPROJ + col0;
                f32x4 cs0 = (f32x4){1.f, 0.f, 1.f, 0.f}, cs1 = cs0;
                if (rot) { const int pos = row < HALF_TOK ? (row & 8191) : ((row - HALF_TOK) & 2047); const f32x2* rp = rope + (size_t)pos * 64 + i0; cs0 = *(const f32x4*)rp; cs1 = *(const f32x4*)(rp + 2); }
#pragma unroll
                for (int bj = 0; bj < 2; ++bj) { f32x4 v0 = acc[ai][bj][m][0], v1 = acc[ai][bj][m][1];
                    if (rot) { const f32x4 a = v0, b = v1;
                        v0[0] = a[0] * cs0[0] - a[1] * cs0[1]; v0[1] = a[1] * cs0[0] + a[0] * cs0[1]; v0[2] = a[2] * cs0[2] - a[3] * cs0[3]; v0[3] = a[3] * cs0[2] + a[2] * cs0[3];
                        v1[0] = b[0] * cs1[0] - b[1] * cs1[1]; v1[1] = b[1] * cs1[0] + b[0] * cs1[1]; v1[2] = b[2] * cs1[2] - b[3] * cs1[3]; v1[3] = b[3] * cs1[2] + b[2] * cs1[3]; }
                    u32x4 w; w.x = cvt_pk_bf16(v0[0], v0[1]); w.y = cvt_pk_bf16(v0[2], v0[3]); w.z = cvt_pk_bf16(v1[0], v1[1]); w.w = cvt_pk_bf16(v1[2], v1[3]);
                    *(u32x4*)(rowp + bj * 128) = w; }
                __builtin_amdgcn_sched_barrier(0); }
    }
};
struct EpiG2 {
    const float* x0; const float* x1; float* H; bf16_t* HB; float* rss;
    __device__ __forceinline__ void operator()(AccT& acc, const Unit& u, int wr, int wc, int fr, int fq) const {
        asm volatile("" : "+v"(fr)); asm volatile("" : "+v"(fq));
        const int row0 = u.pm * 256 + wr * 64 + fr, col0 = u.pn * 256 + wc * 32 + 8 * fq;
        f32x4 xv[2][4];
        { const int row = row0; const float* xr = (row < HALF_TOK ? x0 + (size_t)row * DM : x1 + (size_t)(row - HALF_TOK) * DM) + col0;
          xv[0][0] = NTL(xr); xv[0][1] = NTL(xr + 4); xv[0][2] = NTL(xr + 128); xv[0][3] = NTL(xr + 132); }
#pragma unroll
        for (int r = 0; r < 8; ++r) { const int ai = r >> 2, m = r & 3; const int row = row0 + ai * 128 + m * 16;
            if (r < 7) { const int rn = row0 + ((r + 1) >> 2) * 128 + ((r + 1) & 3) * 16; const float* xr = (rn < HALF_TOK ? x0 + (size_t)rn * DM : x1 + (size_t)(rn - HALF_TOK) * DM) + col0;
                xv[(r + 1) & 1][0] = NTL(xr); xv[(r + 1) & 1][1] = NTL(xr + 4); xv[(r + 1) & 1][2] = NTL(xr + 128); xv[(r + 1) & 1][3] = NTL(xr + 132); }
            float* hr = H + (size_t)row * DM + col0; float ss = 0.f;
#pragma unroll
            for (int bj = 0; bj < 2; ++bj) {
                f32x4 v0 = acc[ai][bj][m][0] + xv[r & 1][2 * bj], v1 = acc[ai][bj][m][1] + xv[r & 1][2 * bj + 1];
                NTS(v0, hr + bj * 128); NTS(v1, hr + bj * 128 + 4);
                u32x4 w; w.x = cvt_pk_bf16(v0[0], v0[1]); w.y = cvt_pk_bf16(v0[2], v0[3]); w.z = cvt_pk_bf16(v1[0], v1[1]); w.w = cvt_pk_bf16(v1[2], v1[3]);
                *(u32x4*)(HB + (size_t)row * DM + col0 + bj * 128) = w;
#pragma unroll
                for (int j = 0; j < 4; ++j) ss += v0[j] * v0[j] + v1[j] * v1[j]; }
            ss += __shfl_xor(ss, 16); ss += __shfl_xor(ss, 32);
            if (fq == 0) unsafeAtomicAdd(rss + row, ss); __builtin_amdgcn_sched_barrier(0); }
    }
};
struct EpiF12 {
    bf16_t* ACT; bf16_t* GR; bf16_t* UP; const float* rss; const float* cw; const float* cb; int half;
    __device__ __forceinline__ void operator()(AccT& acc, const Unit& u, int wr, int wc, int fr, int fq) const {
        asm volatile("" : "+v"(fr)); asm volatile("" : "+v"(fq));
        const int fcol = u.pn * 128 + wc * 32 + 8 * fq;
#pragma unroll
        for (int ai = 0; ai < 2; ++ai) { const int gidx = u.pm * 4 + ai * 2 + wr;
#pragma unroll
            for (int m = 0; m < 4; ++m) { const float rstd = rsqrtf(rss[half * HALF_TOK + gidx * 64 + m * 16 + fr] * (1.0f / DM) + 1e-6f);
#pragma unroll
                for (int n = 0; n < 2; ++n) { acc[ai][0][m][n] = acc[ai][0][m][n] * rstd; acc[ai][1][m][n] = acc[ai][1][m][n] * rstd; } }
#pragma unroll
            for (int n = 0; n < 2; ++n) {
                const f32x4 w0 = *(const f32x4*)(cw + fcol + 4 * n), w1 = *(const f32x4*)(cw + DFF + fcol + 4 * n), w2 = *(const f32x4*)(cw + 2 * DFF + fcol + 4 * n), b = *(const f32x4*)(cb + fcol + 4 * n);
#pragma unroll
                for (int m = 0; m < 4; ++m) { const int lr = m * 16 + fr;
                    const f32x4 gc = acc[ai][0][m][n], up = acc[ai][1][m][n]; f32x4 uu;
#pragma unroll
                    for (int j = 0; j < 4; ++j) { const float gp = dppf_prev(gc[j], m > 0 ? acc[ai][0][m - 1][n][j] : 0.f), gn = dppf_next(gc[j], m < 3 ? acc[ai][0][m + 1][n][j] : 0.f);
                        uu[j] = gp * w0[j] + gc[j] * w1[j] + gn * w2[j] + b[j]; }
                    const f32x2 ga = gelu_pk((f32x2){uu[0], uu[1]}), gb = gelu_pk((f32x2){uu[2], uu[3]});
                    u32x2 wa; wa.x = cvt_pk_bf16(ga.x * up[0], ga.y * up[1]); wa.y = cvt_pk_bf16(gb.x * up[2], gb.y * up[3]);
                    *(u32x2*)(ACT + (size_t)(gidx * 64 + lr) * DFF + fcol + 4 * n) = wa;
                    if (m == 0 || m == 3) {
                        if (lr == 0 || lr == 63) { u32x2 wu; wu.x = cvt_pk_bf16(up[0], up[1]); wu.y = cvt_pk_bf16(up[2], up[3]); *(u32x2*)(UP + (size_t)(gidx * 2 + (lr == 63 ? 1 : 0)) * DFF + fcol + 4 * n) = wu; }
                        if (lr < 2 || lr > 61) { u32x2 wg; wg.x = cvt_pk_bf16(gc[0], gc[1]); wg.y = cvt_pk_bf16(gc[2], gc[3]); *(u32x2*)(GR + (size_t)(gidx * 4 + (lr < 2 ? lr : lr - 60)) * DFF + fcol + 4 * n) = wg; } } } }
        }
    }
};
__device__ void ffn_fix(bf16_t* ACT, const bf16_t* GR, const bf16_t* UP, const float* cw, const float* cb, int pm, int half) {
    int tid = threadIdx.x; asm volatile("" : "+v"(tid));
    const int seqgroups = half ? 32 : 128;
    for (int it = tid; it < 8 * 352; it += 512) { const int br = it / 352, col = (it % 352) * 8; const int group = pm * 4 + (br >> 1), which = br & 1;
        const bool seq_first = (group % seqgroups) == 0, seq_last = (group % seqgroups) == seqgroups - 1;
        const bf16_t* pp = which ? GR + (size_t)(group * 4 + 2) * DFF : GR + (size_t)((seq_first ? group : group - 1) * 4 + 3) * DFF;
        const bf16_t* pc = GR + (size_t)(group * 4 + (which ? 3 : 0)) * DFF;
        const bf16_t* pn = which ? GR + (size_t)((seq_last ? group : group + 1) * 4 + 0) * DFF : GR + (size_t)(group * 4 + 1) * DFF;
        const float mp = (!which && seq_first) ? 0.f : 1.f, mn = (which && seq_last) ? 0.f : 1.f;
        const u32x4 gp = *(const u32x4*)(pp + col), gc = *(const u32x4*)(pc + col), gn = *(const u32x4*)(pn + col), up = *(const u32x4*)(UP + (size_t)(group * 2 + which) * DFF + col);
        u32x4 ov;
#pragma unroll
        for (int q = 0; q < 4; ++q) { const int c = col + 2 * q;
            const float u0 = bf_lo(gp[q]) * mp * cw[c] + bf_lo(gc[q]) * cw[DFF + c] + bf_lo(gn[q]) * mn * cw[2 * DFF + c] + cb[c];
            const float u1 = bf_hi(gp[q]) * mp * cw[c + 1] + bf_hi(gc[q]) * cw[DFF + c + 1] + bf_hi(gn[q]) * mn * cw[2 * DFF + c + 1] + cb[c + 1];
            const f32x2 ge = gelu_pk((f32x2){u0, u1}); ov[q] = cvt_pk_bf16(ge.x * bf_lo(up[q]), ge.y * bf_hi(up[q])); }
        *(u32x4*)(ACT + (size_t)(group * 64 + (which ? 63 : 0)) * DFF + col) = ov; }
    asm volatile("s_waitcnt vmcnt(0)" ::: "memory"); __syncthreads();
}
struct EpiF3 {
    float* H; bf16_t* HB; float* rss; int half;
    __device__ __forceinline__ void operator()(AccT& acc, const Unit& u, int wr, int wc, int fr, int fq) const {
        asm volatile("" : "+v"(fr)); asm volatile("" : "+v"(fq));
        const int row0 = half * HALF_TOK + u.pm * 256 + wr * 64 + fr, col0 = u.pn * 256 + wc * 32 + 8 * fq;
        f32x4 hv[2][4];
        { const float* hr = H + (size_t)row0 * DM + col0; hv[0][0] = NTL(hr); hv[0][1] = NTL(hr + 4); hv[0][2] = NTL(hr + 128); hv[0][3] = NTL(hr + 132); }
#pragma unroll
        for (int r = 0; r < 8; ++r) { const int ai = r >> 2, m = r & 3; const int row = row0 + ai * 128 + m * 16;
            if (r < 7) { const int rn = row0 + ((r + 1) >> 2) * 128 + ((r + 1) & 3) * 16; const float* hn = H + (size_t)rn * DM + col0;
                hv[(r + 1) & 1][0] = NTL(hn); hv[(r + 1) & 1][1] = NTL(hn + 4); hv[(r + 1) & 1][2] = NTL(hn + 128); hv[(r + 1) & 1][3] = NTL(hn + 132); }
            float* hr = H + (size_t)row * DM + col0; float ss = 0.f;
#pragma unroll
            for (int bj = 0; bj < 2; ++bj) {
                f32x4 v0 = acc[ai][bj][m][0] + hv[r & 1][2 * bj], v1 = acc[ai][bj][m][1] + hv[r & 1][2 * bj + 1];
                NTS(v0, hr + bj * 128); NTS(v1, hr + bj * 128 + 4);
                u32x4 w; w.x = cvt_pk_bf16(v0[0], v0[1]); w.y = cvt_pk_bf16(v0[2], v0[3]); w.z = cvt_pk_bf16(v1[0], v1[1]); w.w = cvt_pk_bf16(v1[2], v1[3]);
                *(u32x4*)(HB + (size_t)row * DM + col0 + bj * 128) = w;
#pragma unroll
                for (int j = 0; j < 4; ++j) ss += v0[j] * v0[j] + v1[j] * v1[j]; }
            ss += __shfl_xor(ss, 16); ss += __shfl_xor(ss, 32);
            if (fq == 0) unsafeAtomicAdd(rss + row, ss); __builtin_amdgcn_sched_barrier(0); }
    }
};
struct EpiPP {
    bf16_t* T0; bf16_t* T1;
    __device__ __forceinline__ void operator()(AccT& acc, const Unit& u, int wr, int wc, int fr, int fq) const {
        asm volatile("" : "+v"(fr)); asm volatile("" : "+v"(fq));
        bf16_t* base = (u.L < 256 ? T0 : T1) + (size_t)(u.L & 255) * 65536 + (wr * 64 + fr) * 256 + wc * 32 + 8 * fq;
#pragma unroll
        for (int ai = 0; ai < 2; ++ai)
#pragma unroll
            for (int m = 0; m < 4; ++m) { bf16_t* rowp = base + (ai * 128 + m * 16) * 256;
#pragma unroll
                for (int bj = 0; bj < 2; ++bj) { const f32x4 v0 = acc[ai][bj][m][0], v1 = acc[ai][bj][m][1];
                    u32x4 w; w.x = cvt_pk_bf16(v0[0], v0[1]); w.y = cvt_pk_bf16(v0[2], v0[3]); w.z = cvt_pk_bf16(v1[0], v1[1]); w.w = cvt_pk_bf16(v1[2], v1[3]);
                    *(u32x4*)(rowp + bj * 128) = w; } }
    }
};
struct EpiPG {
    const bf16_t* T0; const bf16_t* T1; float* H; const float* rss2; const float* bias; float* rss3;
    __device__ __forceinline__ void operator()(AccT& acc, const Unit& u, int wr, int wc, int fr, int fq) const {
        asm volatile("" : "+v"(fr)); asm volatile("" : "+v"(fq));
        const int row0 = u.pm * 256 + wr * 64 + fr, col0 = u.pn * 256 + wc * 32 + 8 * fq;
        f32x4 hv[2][4]; u32x4 pv[2][2]; float rs[2];
        const bf16_t* ppbase = (u.L < 256 ? T0 : T1) + (size_t)(u.L & 255) * 65536 + (wr * 64 + fr) * 256 + wc * 32 + 8 * fq;
        { const float* hr = H + (size_t)row0 * DM + col0; const bf16_t* pp = ppbase;
          hv[0][0] = NTL(hr); hv[0][1] = NTL(hr + 4); hv[0][2] = NTL(hr + 128); hv[0][3] = NTL(hr + 132);
          pv[0][0] = *(const u32x4*)pp; pv[0][1] = *(const u32x4*)(pp + 128); rs[0] = rss2[row0]; }
#pragma unroll
        for (int r = 0; r < 8; ++r) { const int ai = r >> 2, m = r & 3; const int row = row0 + ai * 128 + m * 16;
            if (r < 7) { const int rn = row0 + ((r + 1) >> 2) * 128 + ((r + 1) & 3) * 16; const float* hn = H + (size_t)rn * DM + col0; const bf16_t* pn = ppbase + (((r + 1) >> 2) * 128 + ((r + 1) & 3) * 16) * 256;
                hv[(r + 1) & 1][0] = NTL(hn); hv[(r + 1) & 1][1] = NTL(hn + 4); hv[(r + 1) & 1][2] = NTL(hn + 128); hv[(r + 1) & 1][3] = NTL(hn + 132);
                pv[(r + 1) & 1][0] = *(const u32x4*)pn; pv[(r + 1) & 1][1] = *(const u32x4*)(pn + 128); rs[(r + 1) & 1] = rss2[rn]; }
            float* hp = H + (size_t)row * DM + col0; float ss = 0.f; const float rstd = rsqrtf(rs[r & 1] * (1.0f / DM) + 1e-6f);
#pragma unroll
            for (int bj = 0; bj < 2; ++bj) { const u32x4 pw = pv[r & 1][bj];
                const f32x4 b0 = *(const f32x4*)(bias + col0 + bj * 128), b1 = *(const f32x4*)(bias + col0 + bj * 128 + 4);
                const f32x4 p0 = (f32x4){bf_lo(pw.x), bf_hi(pw.x), bf_lo(pw.y), bf_hi(pw.y)}, p1 = (f32x4){bf_lo(pw.z), bf_hi(pw.z), bf_lo(pw.w), bf_hi(pw.w)};
                f32x4 g0 = acc[ai][bj][m][0] * rstd + b0, g1 = acc[ai][bj][m][1] * rstd + b1;
#pragma unroll
                for (int j = 0; j < 4; ++j) { g0[j] = sigmoidf_(g0[j]); g1[j] = sigmoidf_(g1[j]); }
                const f32x4 v0 = hv[r & 1][2 * bj] + p0 * g0, v1 = hv[r & 1][2 * bj + 1] + p1 * g1;
                NTS(v0, hp + bj * 128); NTS(v1, hp + bj * 128 + 4);
#pragma unroll
                for (int j = 0; j < 4; ++j) ss += v0[j] * v0[j] + v1[j] * v1[j]; }
            ss += __shfl_xor(ss, 16); ss += __shfl_xor(ss, 32);
            if (fq == 0) unsafeAtomicAdd(rss3 + row, ss); __builtin_amdgcn_sched_barrier(0); }
    }
};

__device__ void wt_tile(const float* src, int ld, int k0, int n0, bf16_t* dst, int Kdst, const float* kscale, float mul, LAS float* tile, bool rotperm = false, int drow0 = -1) {
    int tid = threadIdx.x; asm volatile("" : "+v"(tid));
    float v[16];
#pragma unroll
    for (int i = 0; i < 16; ++i) { const int k = (tid >> 7) + 4 * i, n = tid & 127; v[i] = src[(size_t)(k0 + k) * ld + n0 + n]; }
#pragma unroll
    for (int i = 0; i < 16; ++i) { const int k = (tid >> 7) + 4 * i, n = tid & 127; float x = v[i] * mul; if (kscale) x *= kscale[k0 + k]; tile[k * 129 + n] = x; }
    __syncthreads();
#pragma unroll
    for (int i = 0; i < 8; ++i) { const int n = (tid >> 5) + 16 * i, k2 = (tid & 31) * 2;
        const float a = tile[k2 * 129 + n], b = tile[(k2 + 1) * 129 + n]; int nn = (drow0 >= 0 ? drow0 : n0) + n; if (rotperm) nn = (nn & ~127) | (2 * (nn & 63) + ((nn >> 6) & 1));
        *(unsigned*)(dst + (size_t)nn * Kdst + k0 + k2) = cvt_pk_bf16(a, b); }
    __syncthreads();
}
__device__ void convert_rest(const Params& P, LAS float* tile, int sub, int nsub) {
    unsigned char* dob = (unsigned char*)P.out;
    const int T2 = 16 * 8, T3 = 16 * 22, T4 = 16 * 22, T5 = 44 * 8, TT = T2 + T3 + T4 + T5;
    for (int t = sub; t < TT; t += nsub) {
        if (t < T2) { const int kt = t & 15, ntl = t >> 4; wt_tile(P.in[12], DM, kt * 64, ntl * 128, (bf16_t*)(dob + DO_WOT), DM, nullptr, 1.0f, tile); }
        else if (t < T2 + T3) { const int u = t - T2, kt = u & 15, ntl = u >> 4; wt_tile(P.in[14], DFF, kt * 64, ntl * 128, (bf16_t*)(dob + DO_WGT), DM, P.in[13], 1.0f, tile, false, ntl * 256); }
        else if (t < T2 + T3 + T4) { const int u = t - T2 - T3, kt = u & 15, ntl = u >> 4; wt_tile(P.in[15], DFF, kt * 64, ntl * 128, (bf16_t*)(dob + DO_WGT), DM, P.in[13], 1.0f, tile, false, ntl * 256 + 128); }
        else { const int u = t - T2 - T3 - T4, kt = u % 44, ntl = u / 44; wt_tile(P.in[18], DM, kt * 64, ntl * 128, (bf16_t*)(dob + DO_WDT), DFF, nullptr, 1.0f, tile); }
    }
}

__device__ void phase0(const Params& P, LAS unsigned char* lds, const int G, const int bid) {
    int tid = threadIdx.x; asm volatile("" : "+v"(tid));
    const int wid = tid >> 6, lane = tid & 63;
    unsigned char* dob = (unsigned char*)P.out;
    { float* r1 = (float*)(dob + DO_RSS1); for (int i = bid * 512 + tid; i < NTOK; i += G * 512) r1[i] = 0.f; }
    { f32x2* rope = (f32x2*)(dob + DO_ROPE);
      for (int i = bid * 512 + tid; i < 8192 * 64; i += G * 512) { const int pos = i >> 6, f = i & 63;
          const float inv = powf(10000.0f, -(float)(2 * f) / 128.0f); const float ang = (float)pos * inv; float s, c; sincosf(ang, &s, &c); rope[i] = (f32x2){c, s}; } }
    { LAS float* tile = (LAS float*)lds;
      for (int t = bid; t < 512; t += G) { const int kt = t & 15, ntl = t >> 4; wt_tile(P.in[5], INCOLS, kt * 64, ntl * 128, (bf16_t*)(dob + DO_W1T), DM, nullptr, ntl < 4 ? 0.08838834764831845f : 1.0f, tile, ntl < 8); } }
    LAS float* wg = (LAS float*)(lds + 40960);
    { const float* win = P.in[5];
#pragma unroll
      for (int i = 0; i < 8; ++i) { const int k = (tid >> 2) + 128 * i, q = tid & 3; const f32x4 v = *(const f32x4*)(win + (size_t)k * INCOLS + NPROJ + 4 * q);
          const int slot = (k & 3) * 256 + (k >> 8) * 64 + ((k >> 2) & 63); *(LAS f32x4*)(wg + slot * 20 + 4 * q) = v; }
      __syncthreads(); }
    { bf16_t* abf = (bf16_t*)(dob + DO_ABF); float* gates = (float*)(dob + DO_GATES);
      const float* nw = P.in[4]; const float* gb = P.in[8];
      f32x4 w4[4];
#pragma unroll
      for (int i = 0; i < 4; ++i) w4[i] = *(const f32x4*)(nw + 4 * lane + 256 * i);
      const int gcol = ((lane >> 5) & 1) * 8 + ((lane >> 4) & 1) * 4 + ((lane >> 3) & 1) * 2 + ((lane >> 2) & 1);
      const float gbias = gb[gcol];
      for (int row0 = bid * 8 + wid; row0 < NTOK; row0 += G * 8 * 4) {
          f32x4 vv[4][4];
#pragma unroll
          for (int rr = 0; rr < 4; ++rr) { const int row = row0 + rr * G * 8; const float* xr = xrow(P, row < NTOK ? row : row0);
#pragma unroll
              for (int i = 0; i < 4; ++i) vv[rr][i] = __builtin_nontemporal_load((const f32x4*)(xr + 4 * lane + 256 * i)); }
#pragma unroll
          for (int rr = 0; rr < 4; ++rr) { const int row = row0 + rr * G * 8; if (row >= NTOK) continue;
              f32x4 (&v)[4] = vv[rr]; float ss = 0.f;
#pragma unroll
              for (int i = 0; i < 4; ++i)
#pragma unroll
                  for (int j = 0; j < 4; ++j) ss += v[i][j] * v[i][j];
#pragma unroll
              for (int o = 32; o >= 1; o >>= 1) ss += __shfl_xor(ss, o);
              const float rstd = rsqrtf(ss * (1.0f / DM) + 1e-6f);
              float ga[16];
#pragma unroll
              for (int c = 0; c < 16; ++c) ga[c] = 0.f;
#pragma unroll
              for (int i = 0; i < 4; ++i) { v[i] = v[i] * rstd * w4[i];
                  u32x2 w; w.x = cvt_pk_bf16(v[i][0], v[i][1]); w.y = cvt_pk_bf16(v[i][2], v[i][3]);
                  *(u32x2*)(abf + (size_t)row * DM + 4 * lane + 256 * i) = w;
#pragma unroll
                  for (int j = 0; j < 4; ++j) { const LAS float* wr_ = wg + (j * 256 + i * 64 + lane) * 20; const float a = v[i][j];
#pragma unroll
                      for (int q = 0; q < 4; ++q) { const f32x4 wv = *(const LAS f32x4*)(wr_ + 4 * q);
                          ga[4 * q] += a * wv[0]; ga[4 * q + 1] += a * wv[1]; ga[4 * q + 2] += a * wv[2]; ga[4 * q + 3] += a * wv[3]; } } }
              float r8[8], r4[4], r2[2], r1;
#pragma unroll
              for (int c = 0; c < 8; ++c) { const bool hi = (lane & 32) != 0; const float send = hi ? ga[c] : ga[c + 8], keep = hi ? ga[c + 8] : ga[c]; r8[c] = keep + __shfl_xor(send, 32); }
#pragma unroll
              for (int c = 0; c < 4; ++c) { const bool hi = (lane & 16) != 0; const float send = hi ? r8[c] : r8[c + 4], keep = hi ? r8[c + 4] : r8[c]; r4[c] = keep + __shfl_xor(send, 16); }
#pragma unroll
              for (int c = 0; c < 2; ++c) { const bool hi = (lane & 8) != 0; const float send = hi ? r4[c] : r4[c + 2], keep = hi ? r4[c + 2] : r4[c]; r2[c] = keep + __shfl_xor(send, 8); }
              { const bool hi = (lane & 4) != 0; const float send = hi ? r2[0] : r2[1], keep = hi ? r2[1] : r2[0]; r1 = keep + __shfl_xor(send, 4); }
              r1 += __shfl_xor(r1, 2); r1 += __shfl_xor(r1, 1);
              if ((lane & 3) == 0) { float gv = r1 + gbias; if (gcol >= 8) gv = logsigmoidf_(gv); gates[(size_t)row * 16 + gcol] = gv; }
          }
      } }
}

__device__ void phase_conv(const Params& P, const int G, const int bid) {
    int tid = threadIdx.x; asm volatile("" : "+v"(tid));
    unsigned char* dob = (unsigned char*)P.out;
    bf16_t* proj = (bf16_t*)(P.ws + WS_PROJ); const bf16_t* HQ = (const bf16_t*)(dob + DO_HQ);
    const float* cw = P.in[6]; const float* cbv = P.in[7];
    for (int it = bid * 512 + tid; it < 512 * 2 * 128; it += G * 512) { const int ch = it & 127, which = (it >> 7) & 1, g = it >> 8; const int col = ch * 8;
        const int gs = g < 256 ? (g & 127) : ((g - 256) & 31), ng = g < 256 ? 128 : 32; const bool seq_first = gs == 0, seq_last = gs == ng - 1;
        const bf16_t* pp = which ? HQ + (size_t)(g * 4 + 2) * 1024 : HQ + (size_t)((seq_first ? g : g - 1) * 4 + 3) * 1024;
        const bf16_t* pc = HQ + (size_t)(g * 4 + (which ? 3 : 0)) * 1024;
        const bf16_t* pn = which ? HQ + (size_t)((seq_last ? g : g + 1) * 4 + 0) * 1024 : HQ + (size_t)(g * 4 + 1) * 1024;
        const float mp = (!which && seq_first) ? 0.f : 1.f, mn = (which && seq_last) ? 0.f : 1.f, mul = col < 512 ? 0.08838834764831845f : 1.0f;
        const u32x4 gp = *(const u32x4*)(pp + col), gc = *(const u32x4*)(pc + col), gn = *(const u32x4*)(pn + col); u32x4 ov;
#pragma unroll
        for (int q = 0; q < 4; ++q) { const int c = col + 2 * q;
            const float u0 = bf_lo(gp[q]) * mp * cw[c] + bf_lo(gc[q]) * cw[1024 + c] + bf_lo(gn[q]) * mn * cw[2048 + c] + cbv[c];
            const float u1 = bf_hi(gp[q]) * mp * cw[c + 1] + bf_hi(gc[q]) * cw[1024 + c + 1] + bf_hi(gn[q]) * mn * cw[2048 + c + 1] + cbv[c + 1];
            ov[q] = cvt_pk_bf16(u0 * sigmoidf_(u0) * mul, u1 * sigmoidf_(u1) * mul); }
        *(u32x4*)(proj + (size_t)(g * 64 + (which ? 63 : 0)) * NPROJ + 2048 + col) = ov; }
}

constexpr unsigned IMG_Q = 0, IMG_K = 32768, IMG_V = 65536, IMG_C = 98304, IMG_VX = 131072, IMG_CX = 135168, VEC0 = 139264;
__device__ __forceinline__ unsigned offb(unsigned row, unsigned ch) { return 256u * row + 16u * (ch ^ (((row & 3u) << 2) | ((row >> 2) & 3u))); }
struct FragB { unsigned rb[4], lp, L16, txb, rp, X16; };
__device__ __forceinline__ void fragb_init(FragB& F, int w, int fr, int fg) {
    const unsigned q = fr >> 2, p = fr & 3, swr = ((fr & 3u) << 2) | ((fr >> 2) & 3u);
#pragma unroll
    for (int s = 0; s < 4; ++s) { unsigned v = 256u * fr + 16u * ((4u * s + fg) ^ swr); asm volatile("" : "+v"(v)); F.rb[s] = v; }
    const unsigned L = (q << 2) | ((fg & 1u) << 1) | (p >> 1);
    F.lp = 256u * (8u * fg + q) + 8u * (p & 1u); F.L16 = 16u * L;
    F.txb = 32u * (8u * fg + q) + 8u * p;
    F.rp = 256u * (16u * w + fr) + 8u * (fg & 1u); F.X16 = 16u * ((fg >> 1) ^ swr);
    asm volatile("" : "+v"(F.lp)); asm volatile("" : "+v"(F.L16)); asm volatile("" : "+v"(F.txb)); asm volatile("" : "+v"(F.rp)); asm volatile("" : "+v"(F.X16));
}
#define ROWFRAG(img, rowbase, s) (*(const LAS bf16x8*)(lds + (img) + 256u * (rowbase) + FB.rb[s]))
__device__ __forceinline__ bf16x8 trfrag_(LAS unsigned char* lds, unsigned a0, unsigned a1) {
    const s16x4 lo = __builtin_amdgcn_ds_read_tr16_b64_v4i16((LAS s16x4*)(lds + a0));
    const s16x4 hi = __builtin_amdgcn_ds_read_tr16_b64_v4i16((LAS s16x4*)(lds + a1));
    return (bf16x8){lo[0], lo[1], lo[2], lo[3], hi[0], hi[1], hi[2], hi[3]};
}
#define TRA(c, t) (FB.lp + (l16 ^ (16u * (2u * (c) + (t)))))
#define TRFRAG(img, c, ks) trfrag_(lds, (img) + 256u * (32u * (ks)) + TRA(c, 0), (img) + 256u * (32u * (ks) + 4u) + TRA(c, 1))
#define TRFRAGX(img, ks) trfrag_(lds, (img) + 32u * (32u * (ks)) + FB.txb, (img) + 32u * (32u * (ks) + 4u) + FB.txb)
#define CWA(nt) (FB.rp + (x16 ^ (32u * (nt))))
#define LAUNDER_L16 unsigned l16 = FB.L16; asm volatile("" : "+v"(l16));
#define LAUNDER_X16 unsigned x16 = FB.X16; asm volatile("" : "+v"(x16));
#define MFMA16(a, b, c) __builtin_amdgcn_mfma_f32_16x16x32_bf16((a), (b), (c), 0, 0, 0)

__device__ void mix_sweep(const Params& P, LAS unsigned char* lds, int tok0, int pos0, int seqlen, int hd, int dir, bool state_only, bool final_pass,
                          f32x4 (&Cacc)[9], float& m_state, float& aseg_sum, float lgam) {
    int tid = threadIdx.x; asm volatile("" : "+v"(tid));
    const int w = __builtin_amdgcn_readfirstlane(tid >> 6), lane = tid & 63, fr = lane & 15, fg = lane >> 4;
    const bool is_m = hd >= 4; const int h = hd & 3;
    unsigned char* dob = (unsigned char*)P.out;
    const bf16_t* proj = (const bf16_t*)(P.ws + WS_PROJ); const float* gates = (const float*)(dob + DO_GATES);
    const f32x2* rope = (const f32x2*)(dob + DO_ROPE); bf16_t* mixed = (bf16_t*)(dob + DO_MIXED);
    LAS float* vrow = (LAS float*)(lds + VEC0); LAS float* vcol = vrow + 128; LAS float* vwi = vrow + 256; LAS float* vkw = vrow + 384; LAS float* vemt = vrow + 512; LAS float* vsc = vrow + 640;
    const int qcol = is_m ? 2048 + h * 128 : h * 128, kcol = is_m ? 2560 + h * 128 : 512 + h * 128, vcolg = is_m ? 3072 + h * 128 : 1024 + h * 128;
    const int gcol = is_m ? 3584 + h * 128 : 1536 + h * 128, mcol = is_m ? 512 + h * 128 : h * 128;
    const float* gnw = (is_m ? P.in[11] : P.in[10]) + h * 128;
    const float LOG2E = 1.4426950408889634f;
    FragB FB; fragb_init(FB, w, fr, fg);
    unsigned ktb0, ktb1; { const unsigned q = fr >> 2, p = fr & 3, L = (q << 2) | ((fg & 1u) << 1) | (p >> 1); ktb0 = 256u * (8u * fg + q) + 8u * (p & 1u) + 16u * (L ^ (2u * w)); ktb1 = 256u * (8u * fg + q) + 8u * (p & 1u) + 16u * (L ^ (2u * w + 1u)); asm volatile("" : "+v"(ktb0)); asm volatile("" : "+v"(ktb1)); }
    __syncthreads();
    if (!state_only) {
#pragma unroll
        for (int nt = 0; nt < 8; ++nt) { u32x2 v; v.x = cvt_pk_bf16(Cacc[nt][0], Cacc[nt][1]); v.y = cvt_pk_bf16(Cacc[nt][2], Cacc[nt][3]);
            { LAUNDER_X16 *(LAS u32x2*)(lds + IMG_C + CWA(nt)) = v; } }
        { u32x2 v; v.x = cvt_pk_bf16(Cacc[8][0], Cacc[8][1]); v.y = cvt_pk_bf16(Cacc[8][2], Cacc[8][3]); *(LAS u32x2*)(lds + IMG_CX + 32 * (16 * w + fr) + 8 * fg) = v; }
    }
    if (tid < 128) { unsigned zz = 0u; asm volatile("" : "+v"(zz)); u32x4 v0 = (u32x4){is_m ? 0x3F80u : zz, zz, zz, zz}; u32x4 z = (u32x4){zz, zz, zz, zz}; *(LAS u32x4*)(lds + IMG_VX + 32 * tid) = v0; *(LAS u32x4*)(lds + IMG_VX + 32 * tid + 16) = z; }
    LAS float* PV = (LAS float*)(lds + 141888); LAS float* PS = PV + 8 * 3 * 128;
    if (is_m) { const int c = dir ? 7 - w : w; const int tokc = tok0 + c * 128;
        const int u0 = 2 * lane, u1 = 2 * lane + 1; const int j0 = dir ? 127 - u0 : u0, j1 = dir ? 127 - u1 : u1;
        const float x0 = gates[(size_t)(tokc + j0) * 16 + 8 + dir * 4 + h], x1 = gates[(size_t)(tokc + j1) * 16 + 8 + dir * 4 + h];
        const float i0 = gates[(size_t)(tokc + j0) * 16 + dir * 4 + h], i1 = gates[(size_t)(tokc + j1) * 16 + dir * 4 + h];
        const float ps = x0 + x1; float sc = ps;
#pragma unroll
        for (int o = 1; o < 64; o <<= 1) { const float t = __shfl_up(sc, o); if (lane >= o) sc += t; }
        const float excl = sc - ps, A0 = excl + x0, A1 = excl + ps, Atot = __shfl(sc, 63);
        const float b0 = i0 - A0, b1 = i1 - A1; const float pm = fmaxf(b0, b1); float scm = pm;
#pragma unroll
        for (int o = 1; o < 64; o <<= 1) { const float t = __shfl_up(scm, o); if (lane >= o) scm = fmaxf(scm, t); }
        float exm = __shfl_up(scm, 1); if (lane == 0) exm = -3.0e38f;
        const float rb0 = fmaxf(exm, b0), rb1 = fmaxf(rb0, b1), bmax = __shfl(scm, 63);
        LAS float* pv = PV + w * 384;
        pv[j0] = A0; pv[j1] = A1; pv[128 + j0] = b0; pv[128 + j1] = b1; pv[256 + j0] = rb0; pv[256 + j1] = rb1;
        if (lane == 0) { PS[2 * w] = Atot; PS[2 * w + 1] = bmax; }
    } else if (tid < 128) { const int j = tid, u = dir ? 127 - j : j; const float A = (float)(u + 1) * lgam, Atot = 128.0f * lgam;
        vrow[j] = A * LOG2E; vcol[j] = -A * LOG2E; vwi[j] = __expf(A); vkw[j] = __expf(Atot - A); vemt[j] = 1.f; if (j == 0) vsc[0] = __expf(Atot); }
    u32x4 t[3][4];
    { const int c = dir ? 7 : 0; const int tok = tok0 + c * 128;
#pragma unroll
      for (int which = 1; which < 3; ++which) { const int cb = which == 0 ? qcol : (which == 1 ? kcol : vcolg);
#pragma unroll
          for (int it = 0; it < 4; ++it) { const int item = tid + 512 * it, r = item >> 4, ch = item & 15; t[which][it] = *(const u32x4*)(proj + (size_t)(tok + r) * NPROJ + cb + 8 * ch); } } }
    for (int ci = 0; ci < 8; ++ci) {
        const int c = dir ? 7 - ci : ci; const int tok = tok0 + c * 128;
        __syncthreads();
        int tl = tid; asm volatile("" : "+v"(tl));
        if (!state_only) {
#pragma unroll
            for (int it = 0; it < 4; ++it) { const int item = tl + 512 * it, r = item >> 4, ch = item & 15; t[0][it] = *(const u32x4*)(proj + (size_t)(tok + r) * NPROJ + qcol + 8 * ch); } }
#pragma unroll
        for (int which = 2; which >= 0; --which) { if (which == 0 && state_only) continue; LAS unsigned char* img = lds + (which == 0 ? IMG_Q : (which == 1 ? IMG_K : IMG_V));
#pragma unroll
            for (int it = 0; it < 4; ++it) { const int item = tl + 512 * it, r = item >> 4, ch = item & 15; *(LAS u32x4*)(img + offb(r, ch)) = t[which][it]; } }
        if (ci < 7) { const int cn = dir ? 6 - ci : ci + 1; const int tokn = tok0 + cn * 128;
#pragma unroll
            for (int which = 1; which < 3; ++which) { const int cb = which == 1 ? kcol : vcolg;
#pragma unroll
                for (int it = 0; it < 4; ++it) { const int item = tl + 512 * it, r = item >> 4, ch = item & 15; t[which][it] = *(const u32x4*)(proj + (size_t)(tokn + r) * NPROJ + cb + 8 * ch); } } }
        if (is_m) { const float Atot = PS[2 * ci], bmax = PS[2 * ci + 1]; const float mprev = m_state, Ml = fmaxf(mprev, bmax);
            if (tid < 128) { const int j = tid; LAS float* pv = PV + ci * 384; const float A = pv[j], b = pv[128 + j], rb = pv[256 + j]; const float M = fmaxf(mprev, rb);
                vrow[j] = -M * LOG2E; vcol[j] = b * LOG2E; vwi[j] = __expf(mprev - M); vkw[j] = __expf(b - Ml); vemt[j] = __expf(-(A + M)); if (j == 0) vsc[0] = __expf(mprev - Ml); }
            m_state = Atot + Ml; aseg_sum += Atot;
        } else aseg_sum += 128.0f * lgam;
        __syncthreads();
        const float decay = vsc[0];
        if (!state_only) {
            int irow = 16 * w + fr; asm volatile("" : "+v"(irow));
            bf16x8 qf[4];
#pragma unroll
            for (int s = 0; s < 4; ++s) qf[s] = ROWFRAG(IMG_Q, 16 * w, s);
            f32x4 O[9];
            __builtin_amdgcn_s_setprio(1);
#pragma unroll
            for (int nt = 0; nt < 8; ++nt) { f32x4 a = (f32x4){0.f, 0.f, 0.f, 0.f}; LAUNDER_L16
                bf16x8 cf[4];
#pragma unroll
                for (int ks = 0; ks < 4; ++ks) cf[ks] = TRFRAG(IMG_C, nt, ks);
                __builtin_amdgcn_sched_barrier(0);
#pragma unroll
                for (int ks = 0; ks < 4; ++ks) a = MFMA16(cf[ks], qf[ks], a);
                O[nt] = a; }
            { f32x4 a = (f32x4){0.f, 0.f, 0.f, 0.f};
              if (is_m) { bf16x8 xf[4];
#pragma unroll
                  for (int ks = 0; ks < 4; ++ks) xf[ks] = TRFRAGX(IMG_CX, ks);
                  __builtin_amdgcn_sched_barrier(0);
#pragma unroll
                  for (int ks = 0; ks < 4; ++ks) a = MFMA16(xf[ks], qf[ks], a); }
              O[8] = a; }
            __builtin_amdgcn_s_setprio(0);
            const float wi = vwi[irow], rt = vrow[irow];
#pragma unroll
            for (int nt = 0; nt < 9; ++nt) O[nt] = O[nt] * wi;
#pragma unroll
            for (int nt = 0; nt < 8; ++nt) { f32x4 a = (f32x4){0.f, 0.f, 0.f, 0.f}; bf16x8 kr[4];
#pragma unroll
                for (int s = 0; s < 4; ++s) kr[s] = ROWFRAG(IMG_K, 16 * nt, s);
                __builtin_amdgcn_sched_barrier(0);
#pragma unroll
                for (int s = 0; s < 4; ++s) a = MFMA16(kr[s], qf[s], a);
                const f32x4 ct = *(const LAS f32x4*)(vcol + 16 * nt + 4 * fg); float p[4];
#pragma unroll
                for (int e = 0; e < 4; ++e) { const int j = 16 * nt + 4 * fg + e;
                    const bool keep = dir ? (is_m ? (j >= irow) : (j > irow)) : (j <= irow);
                    const float ex = __builtin_amdgcn_exp2f(rt + ct[e]); p[e] = keep ? a[e] * ex : 0.f; }
                u32x2 pv; pv.x = cvt_pk_bf16(p[0], p[1]); pv.y = cvt_pk_bf16(p[2], p[3]);
                { LAUNDER_X16 *(LAS u32x2*)(lds + IMG_Q + CWA(nt)) = pv; } __builtin_amdgcn_sched_barrier(0); }
            bf16x8 pf[4];
#pragma unroll
            for (int s = 0; s < 4; ++s) pf[s] = ROWFRAG(IMG_Q, 16 * w, s);
            bf16x8 kf[4];
#pragma unroll
            for (int ks = 0; ks < 4; ++ks) { const bf16x8 raw = trfrag_(lds, IMG_K + 256u * (32u * ks) + ktb0, IMG_K + 256u * (32u * ks + 4u) + ktb1);
                const f32x4 k0 = *(const LAS f32x4*)(vkw + 32 * ks + 8 * fg), k1 = *(const LAS f32x4*)(vkw + 32 * ks + 8 * fg + 4);
                float f[8];
#pragma unroll
                for (int e = 0; e < 8; ++e) f[e] = __uint_as_float(((unsigned)(unsigned short)raw[e]) << 16) * (e < 4 ? k0[e] : k1[e - 4]);
                u32x4 pk; pk.x = cvt_pk_bf16(f[0], f[1]); pk.y = cvt_pk_bf16(f[2], f[3]); pk.z = cvt_pk_bf16(f[4], f[5]); pk.w = cvt_pk_bf16(f[6], f[7]);
                kf[ks] = __builtin_bit_cast(bf16x8, pk); }
            __builtin_amdgcn_s_setprio(1);
#pragma unroll
            for (int nt = 0; nt < 8; ++nt) { LAUNDER_L16
                bf16x8 vf[4];
#pragma unroll
                for (int ks = 0; ks < 4; ++ks) vf[ks] = TRFRAG(IMG_V, nt, ks);
                __builtin_amdgcn_sched_barrier(0);
                f32x4 a = Cacc[nt] * decay;
#pragma unroll
                for (int ks = 0; ks < 4; ++ks) { O[nt] = MFMA16(vf[ks], pf[ks], O[nt]); a = MFMA16(vf[ks], kf[ks], a); }
                Cacc[nt] = a; }
            if (is_m) { f32x4 a = Cacc[8] * decay; bf16x8 vx[4];
#pragma unroll
                for (int ks = 0; ks < 4; ++ks) vx[ks] = TRFRAGX(IMG_VX, ks);
                __builtin_amdgcn_sched_barrier(0);
#pragma unroll
                for (int ks = 0; ks < 4; ++ks) { O[8] = MFMA16(vx[ks], pf[ks], O[8]); a = MFMA16(vx[ks], kf[ks], a); }
                Cacc[8] = a; }
            __builtin_amdgcn_s_setprio(0);
            float hs = 1.0f;
            if (is_m) { const float den = __shfl(O[8][0], fr); hs = 1.0f / fmaxf(fabsf(den), vemt[irow]); }
            bf16_t* mrow = mixed + (size_t)(tok + irow) * DM + mcol + 4 * fg;
            if (!final_pass) {
#pragma unroll
                for (int nt = 0; nt < 8; ++nt) { u32x2 v; v.x = cvt_pk_bf16(O[nt][0] * hs, O[nt][1] * hs); v.y = cvt_pk_bf16(O[nt][2] * hs, O[nt][3] * hs); *(u32x2*)(mrow + 16 * nt) = v; }
            } else {
                float sum = 0.f;
#pragma unroll
                for (int nt = 0; nt < 8; ++nt) { const u32x2 hb = *(const u32x2*)(mrow + 16 * nt);
                    O[nt][0] = O[nt][0] * hs + bf_lo(hb.x); O[nt][1] = O[nt][1] * hs + bf_hi(hb.x); O[nt][2] = O[nt][2] * hs + bf_lo(hb.y); O[nt][3] = O[nt][3] * hs + bf_hi(hb.y);
                    sum += O[nt][0] + O[nt][1] + O[nt][2] + O[nt][3]; __builtin_amdgcn_sched_barrier(0); }
                sum += __shfl_xor(sum, 16); sum += __shfl_xor(sum, 32);
                const float mu = sum * (1.0f / 128.0f); float sq = 0.f;
#pragma unroll
                for (int nt = 0; nt < 8; ++nt)
#pragma unroll
                    for (int e = 0; e < 4; ++e) { const float d = O[nt][e] - mu; sq += d * d; }
                sq += __shfl_xor(sq, 16); sq += __shfl_xor(sq, 32);
                const float rs = rsqrtf(sq * (1.0f / 128.0f) + 1e-5f);
                const bf16_t* grow = proj + (size_t)(tok + irow) * NPROJ + gcol + 4 * fg;
#pragma unroll
                for (int nt = 0; nt < 8; ++nt) { const u32x2 gv = *(const u32x2*)(grow + 16 * nt); const f32x4 gw = *(const f32x4*)(gnw + 16 * nt + 4 * fg);
                    float gt[4] = {bf_lo(gv.x), bf_hi(gv.x), bf_lo(gv.y), bf_hi(gv.y)}; float y[4];
#pragma unroll
                    for (int e = 0; e < 4; ++e) { const float sg = sigmoidf_(gt[e]); const float gate = is_m ? sg : gt[e] * sg; y[e] = (O[nt][e] - mu) * rs * gw[e] * gate; }
                    u32x2 v; v.x = cvt_pk_bf16(y[0], y[1]); v.y = cvt_pk_bf16(y[2], y[3]); *(u32x2*)(mrow + 16 * nt) = v; __builtin_amdgcn_sched_barrier(0); }
            }
        }
        if (state_only) {
            bf16x8 kf[4];
#pragma unroll
            for (int ks = 0; ks < 4; ++ks) { const bf16x8 raw = trfrag_(lds, IMG_K + 256u * (32u * ks) + ktb0, IMG_K + 256u * (32u * ks + 4u) + ktb1);
                const f32x4 k0 = *(const LAS f32x4*)(vkw + 32 * ks + 8 * fg), k1 = *(const LAS f32x4*)(vkw + 32 * ks + 8 * fg + 4);
                float f[8];
#pragma unroll
                for (int e = 0; e < 8; ++e) f[e] = __uint_as_float(((unsigned)(unsigned short)raw[e]) << 16) * (e < 4 ? k0[e] : k1[e - 4]);
                u32x4 pk; pk.x = cvt_pk_bf16(f[0], f[1]); pk.y = cvt_pk_bf16(f[2], f[3]); pk.z = cvt_pk_bf16(f[4], f[5]); pk.w = cvt_pk_bf16(f[6], f[7]);
                kf[ks] = __builtin_bit_cast(bf16x8, pk); }
#pragma unroll
            for (int nt = 0; nt < 8; ++nt) { f32x4 a = Cacc[nt] * decay; LAUNDER_L16
                bf16x8 vf[4];
#pragma unroll
                for (int ks = 0; ks < 4; ++ks) vf[ks] = TRFRAG(IMG_V, nt, ks);
                __builtin_amdgcn_sched_barrier(0);
#pragma unroll
                for (int ks = 0; ks < 4; ++ks) a = MFMA16(vf[ks], kf[ks], a);
                Cacc[nt] = a; }
            if (is_m) { f32x4 a = Cacc[8] * decay; bf16x8 vx[4];
#pragma unroll
                for (int ks = 0; ks < 4; ++ks) vx[ks] = TRFRAGX(IMG_VX, ks);
                __builtin_amdgcn_sched_barrier(0);
#pragma unroll
                for (int ks = 0; ks < 4; ++ks) a = MFMA16(vx[ks], kf[ks], a);
                Cacc[8] = a; }
        }
        if (!state_only) {
            __syncthreads();
#pragma unroll
            for (int nt = 0; nt < 8; ++nt) { u32x2 v; v.x = cvt_pk_bf16(Cacc[nt][0], Cacc[nt][1]); v.y = cvt_pk_bf16(Cacc[nt][2], Cacc[nt][3]);
                { LAUNDER_X16 *(LAS u32x2*)(lds + IMG_C + CWA(nt)) = v; } }
            { u32x2 v; v.x = cvt_pk_bf16(Cacc[8][0], Cacc[8][1]); v.y = cvt_pk_bf16(Cacc[8][2], Cacc[8][3]); *(LAS u32x2*)(lds + IMG_CX + 32 * (16 * w + fr) + 8 * fg) = v; }
        }
    }
}

__device__ __forceinline__ int tot_slot(int sg, int hd, int dir) {
    if (sg < 16) { const int seq = sg >> 3, s = sg & 7; return ((seq * 8 + hd) * 2 + dir) * 7 + (dir ? s - 1 : s); }
    const int seq = (sg - 16) >> 1; return 224 + (seq * 8 + hd) * 2 + dir;
}
__device__ __forceinline__ float head_lgam(const Params& P, int hd, int dir) { return hd < 4 ? logsigmoidf_(P.in[9][dir * 4 + hd]) : 0.f; }

__device__ void phase_mix1(const Params& P, LAS unsigned char* lds, const int G, const int bid) {
    unsigned char* dob = (unsigned char*)P.out; float* tot = (float*)(dob + DO_TOT); float* tots = (float*)(dob + DO_TOTS);
    for (int it = bid; it < NSLOT; it += G) {
        int sg, hd, dir;
        if (it < 224) { const int k = it % 7, r = it / 7; dir = r & 1; hd = (r >> 1) & 7; const int seq = r >> 4; sg = seq * 8 + (dir ? k + 1 : k); }
        else { const int r = it - 224; dir = r & 1; hd = (r >> 1) & 7; const int seq = r >> 4; sg = 16 + seq * 2 + (dir ? 1 : 0); }
        const int seqlen = sg < 16 ? 8192 : 2048; const int pos0 = (sg < 16 ? (sg & 7) : ((sg - 16) & 1)) * 1024;
        f32x4 C[9];
#pragma unroll
        for (int i = 0; i < 9; ++i) C[i] = (f32x4){0.f, 0.f, 0.f, 0.f};
        float m = 0.f, as = 0.f;
        mix_sweep(P, lds, sg * 1024, pos0, seqlen, hd, dir, true, false, C, m, as, head_lgam(P, hd, dir));
        float* tp = tot + ((size_t)it * 512 + threadIdx.x) * 36;
#pragma unroll
        for (int i = 0; i < 9; ++i) *(f32x4*)(tp + 4 * i) = C[i];
        if (threadIdx.x == 0) { tots[it * 2] = m; tots[it * 2 + 1] = as; }
    }
    { const int nfree = G - (NSLOT - G > 0 ? NSLOT - G : 0); const int first = G - nfree;
      __syncthreads();
      if (nfree > 0 && bid >= first) convert_rest(P, (LAS float*)lds, bid - first, nfree);
      else if (nfree <= 0) convert_rest(P, (LAS float*)lds, bid, G); }
}
__device__ void phase_mix2(const Params& P, LAS unsigned char* lds, const int G, const int bid) {
    unsigned char* dob = (unsigned char*)P.out; const float* tot = (const float*)(dob + DO_TOT); const float* tots = (const float*)(dob + DO_TOTS);
    for (int it = bid; it < 256; it += G) {
        const int sg = it >> 3, hd = it & 7;
        const int seqlen = sg < 16 ? 8192 : 2048; const int s = sg < 16 ? (sg & 7) : ((sg - 16) & 1), nseg = sg < 16 ? 8 : 2; const int sg0 = sg - s;
        for (int pass = 0; pass < 2; ++pass) { const int dir = pass ? 0 : 1;
            f32x4 C[9];
#pragma unroll
            for (int i = 0; i < 9; ++i) C[i] = (f32x4){0.f, 0.f, 0.f, 0.f};
            float m = 0.f, as = 0.f;
            const int nfold = dir ? nseg - 1 - s : s;
            for (int f = 0; f < nfold; ++f) { const int sp = dir ? nseg - 1 - f : f; const int slot = tot_slot(sg0 + sp, hd, dir);
                const float mseg = tots[slot * 2], aseg = tots[slot * 2 + 1];
                const float mnew = fmaxf(aseg + m, mseg), d0 = __expf(aseg + m - mnew), d1 = __expf(mseg - mnew);
                const float* tp = tot + ((size_t)slot * 512 + threadIdx.x) * 36;
#pragma unroll
                for (int i = 0; i < 9; ++i) C[i] = C[i] * d0 + *(const f32x4*)(tp + 4 * i) * d1;
                m = mnew; }
            mix_sweep(P, lds, sg * 1024, s * 1024, seqlen, hd, dir, false, pass == 1, C, m, as, head_lgam(P, hd, dir));
        }
    }
}

#define XB_TMO      128
#define XB_XCNT(j)  (256  + 64 * (j))
#define XB_XSUB(j)  (1280 + 64 * (j))
#define XB_XGEN(j)  (2304 + 64 * (j))
#define XB_TOP      3328
#define XB_TOPGEN   3392
#define XCD_BAR_WORDS 3456
#define XB_SPIN_CAP (1u << 18)

__device__ __forceinline__ unsigned xb_ld(unsigned* p)              { return __hip_atomic_load(p, __ATOMIC_RELAXED, __HIP_MEMORY_SCOPE_AGENT); }
__device__ __forceinline__ unsigned xb_add(unsigned* p, unsigned v) { return __hip_atomic_fetch_add(p, v, __ATOMIC_RELAXED, __HIP_MEMORY_SCOPE_AGENT); }
__device__ __forceinline__ unsigned xb_xcc_id() { return (unsigned)__builtin_amdgcn_s_getreg((3 << 11) | 20) & 0xFu; }
#define XB_SPIN(cond, bar) do { unsigned _sp = 0; while (cond) { __builtin_amdgcn_s_sleep(1); \
    if ((++_sp & 255u) == 0u) { if (xb_ld(&(bar)[XB_TMO])) break; if (_sp > XB_SPIN_CAP) { atomicAdd(&(bar)[XB_TMO], 1u); break; } } } } while (0)

struct XcdBarrier {
    unsigned* bar; unsigned x;
    volatile LAS unsigned* st;
};

__device__ __forceinline__ XcdBarrier xcd_barrier_post(unsigned* bar, volatile LAS unsigned* st) {
    XcdBarrier b; b.bar = bar; b.x = xb_xcc_id(); b.st = st;
    if (threadIdx.x == 0) (void)xb_add(&bar[XB_XCNT(b.x)], 1u);
    return b;
}
__device__ __forceinline__ void xcd_barrier_complete(unsigned* bar, unsigned x, unsigned& nloc, unsigned& nx) {
    const unsigned G = gridDim.x * gridDim.y * gridDim.z;
    unsigned sum, cnt, mine, sp = 0u;
    for (;;) {
        sum = 0u; cnt = 0u; mine = 0u;
#pragma unroll
        for (unsigned j = 0; j < 16; ++j) { const unsigned c = xb_ld(&bar[XB_XCNT(j)]); sum += c; cnt += (c > 0u) ? 1u : 0u; mine = (j == x) ? c : mine; }
        if (sum == G) break;
        __builtin_amdgcn_s_sleep(1);
        if ((++sp & 255u) == 0u) { if (xb_ld(&bar[XB_TMO])) break; if (sp > XB_SPIN_CAP) { atomicAdd(&bar[XB_TMO], 1u); break; } }
    }
    nloc = mine > 0u ? mine : 1u; nx = cnt > 0u ? cnt : 1u;
}

__device__ __forceinline__ void xcd_barrier(const XcdBarrier& b) {
    asm volatile("s_waitcnt vmcnt(0)" ::: "memory");
    __syncthreads();
    if (threadIdx.x == 0) {
        unsigned* bar = b.bar;
        __builtin_amdgcn_s_waitcnt(0);
        unsigned nloc = b.st[0], nx = b.st[1];
        if (nloc == 0u) { xcd_barrier_complete(bar, b.x, nloc, nx); b.st[0] = nloc; b.st[1] = nx; }
        const unsigned old = xb_add(&bar[XB_XSUB(b.x)], 1u);
        const unsigned gen = old / nloc;
        if (old + 1u == (gen + 1u) * nloc) {
            __builtin_amdgcn_fence(__ATOMIC_RELEASE, "agent");
            asm volatile("s_waitcnt vmcnt(0)" ::: "memory");
            const unsigned og = xb_add(&bar[XB_TOP], 1u);
            const unsigned tg = og / nx;
            if (og + 1u == (tg + 1u) * nx) xb_add(&bar[XB_TOPGEN], 1u);
            else XB_SPIN(xb_ld(&bar[XB_TOPGEN]) == tg, bar);
            __builtin_amdgcn_fence(__ATOMIC_ACQUIRE, "agent");
            xb_add(&bar[XB_XGEN(b.x)], 1u);
            asm volatile("s_waitcnt vmcnt(0)" ::: "memory");
        } else {
            XB_SPIN(xb_ld(&bar[XB_XGEN(b.x)]) == gen, bar);
            __builtin_amdgcn_fence(__ATOMIC_ACQUIRE, "agent");
            asm volatile("s_waitcnt vmcnt(0)" ::: "memory");
        }
    }
    __syncthreads();
}


__global__ void __launch_bounds__(512, 2) mega(Params P0) {
    extern __shared__ __attribute__((aligned(16))) unsigned char shm[];
    LAS unsigned char* lds = (LAS unsigned char*)shm;
    cg::grid_group grid = cg::this_grid();
    volatile LAS unsigned* xst = (volatile LAS unsigned*)(lds + 155632);
    if (threadIdx.x == 0) { xst[0] = 0u; xst[1] = 0u; }
    __syncthreads();
    XcdBarrier xb = xcd_barrier_post((unsigned*)((unsigned char*)P0.out + DO_BAR), xst);
    typedef const Params __attribute__((address_space(4))) * KArgP;
    const int ph_lo = P0.ph_lo, ph_hi = P0.ph_hi;
    for (int ph = ph_lo; ph <= ph_hi; ++ph) {
        int tid = threadIdx.x; asm volatile("" : "+v"(tid));
        int G = gridDim.x, bid = blockIdx.x; asm volatile("" : "+s"(G)); asm volatile("" : "+s"(bid));
        KArgP kp = (KArgP)__builtin_amdgcn_kernarg_segment_ptr(); asm volatile("" : "+s"(kp));
        Params P;
#pragma unroll
        for (int i = 0; i < 24; ++i) P.in[i] = kp->in[i];
        P.out = kp->out; P.ws = kp->ws; P.ph_lo = 0; P.ph_hi = 0;
        unsigned char* dob = (unsigned char*)P.out; unsigned char* ws = P.ws;
        if (ph == 0) phase0(P, lds, G, bid);
        else if (ph == 1) { pg8::Gemm g{(const bf16_t*)(dob + DO_ABF), (const bf16_t*)(dob + DO_W1T), NTOK, NPROJ, DM}; pg8::StaticOrder S; S.init(NTOK, NPROJ, G, bid);
            EpiProj E{(bf16_t*)(ws + WS_PROJ), (const f32x2*)(dob + DO_ROPE), (bf16_t*)(dob + DO_HQ), P.in[6], P.in[7]}; pg8::gemm_phase(lds, g, S, E); }
        else if (ph == 2) phase_conv(P, G, bid);
        else if (ph == 3) phase_mix1(P, lds, G, bid);
        else if (ph == 4) phase_mix2(P, lds, G, bid);
        else if (ph == 5) {
            { float* r2 = (float*)(ws + WS_RSS2); for (int i = bid * 512 + tid; i < 2 * NTOK; i += G * 512) r2[i] = 0.f;
              if (bid == 0 && tid == 0) __hip_atomic_store((unsigned*)(ws + WS_BAR), 0u, __ATOMIC_RELAXED, __HIP_MEMORY_SCOPE_AGENT); }
            pg8::Gemm g{(const bf16_t*)(dob + DO_MIXED), (const bf16_t*)(dob + DO_WOT), NTOK, DM, DM}; pg8::StaticOrder S; S.init(NTOK, DM, G, bid);
            EpiG2 E{P.in[0], P.in[1], (float*)(ws + WS_H1), (bf16_t*)(ws + WS_H1B), (float*)(dob + DO_RSS1)}; pg8::gemm_phase(lds, g, S, E); }
        else if (ph >= 6 && ph <= 9) { const int half = (ph - 6) >> 1, sub = (ph - 6) & 1;
            const bf16_t* hb = (const bf16_t*)(ws + WS_H1B) + (size_t)half * HALF_TOK * DM;
            if (sub == 0) { pg8::Gemm g{hb, (const bf16_t*)(dob + DO_WGT), HALF_TOK, 2 * DFF, DM}; pg8::StaticOrder S; S.init(HALF_TOK, 2 * DFF, G, bid);
                EpiF12 E{(bf16_t*)(dob + DO_G), (bf16_t*)(dob + DO_GR), (bf16_t*)(dob + DO_UP), (const float*)(dob + DO_RSS1), P.in[16], P.in[17], half}; pg8::gemm_phase(lds, g, S, E);
                if (half == 1) {
                    const int nun = (HALF_TOK / 256) * (2 * DFF / 256), rem = nun % G; const int nfree = rem ? G - rem : 0, sub = rem ? bid - rem : -1;
                    if (sub >= 0) { asm volatile("s_waitcnt vmcnt(0)" ::: "memory"); __syncthreads();
                        pg8::Gemm g2{(const bf16_t*)(ws + WS_PBF), (const bf16_t*)(ws + WS_WPP), NTOK, DM, PLE}; pg8::StaticOrder S2; S2.init(NTOK, DM, nfree, sub); S2.hi = 256;
                        EpiPP E2{(bf16_t*)(ws + WS_PPT), (bf16_t*)dob}; pg8::gemm_phase(lds, g2, S2, E2); } }
                if (half == 0) {
                    const int nun = (HALF_TOK / 256) * (2 * DFF / 256), rem = nun % G; const int nfree = rem ? G - rem : G, sub = rem ? bid - rem : bid;
                    if (sub >= 0) { bf16_t* pbf = (bf16_t*)(ws + WS_PBF); int tid = threadIdx.x; asm volatile("" : "+v"(tid));
                        for (int i = sub * 512 + tid; i < NTOK * PLE / 4; i += nfree * 512) { const int row = i >> 6, c4 = i & 63; const f32x4 v = *(const f32x4*)(prow(P, row) + 4 * c4);
                            u32x2 w; w.x = cvt_pk_bf16(v[0], v[1]); w.y = cvt_pk_bf16(v[2], v[3]); *(u32x2*)(pbf + (size_t)row * PLE + 4 * c4) = w; }
                        LAS float* tile = (LAS float*)lds;
                        for (int t = sub; t < 128 + 32; t += nfree) {
                            if (t < 128) { const int kt = t & 15, ntl = t >> 4; wt_tile(P.in[21], DM, kt * 64, ntl * 128, (bf16_t*)(ws + WS_WPG), DM, P.in[20], 1.0f, tile); }
                            else { const int u2 = t - 128, kt = u2 & 3, ntl = u2 >> 2; wt_tile(P.in[19], DM, kt * 64, ntl * 128, (bf16_t*)(ws + WS_WPP), PLE, nullptr, 1.0f, tile); } } } } }
            else { pg8::Gemm g{(const bf16_t*)(dob + DO_G), (const bf16_t*)(dob + DO_WDT), HALF_TOK, DM, DFF}; pg8::StaticOrder S; S.init(HALF_TOK, DM, G, bid);
                { pg8::Unit uu; int lastpm = -1; for (int i = 0; S.next(i, uu); ++i) if (uu.pm != lastpm) { ffn_fix((bf16_t*)(dob + DO_G), (const bf16_t*)(dob + DO_GR), (const bf16_t*)(dob + DO_UP), P.in[16], P.in[17], uu.pm, half); lastpm = uu.pm; } }
                EpiF3 E{(float*)(ws + WS_H1), (bf16_t*)(ws + WS_H1B), (float*)(ws + WS_RSS2), half}; pg8::gemm_phase(lds, g, S, E); } }
        else if (ph == 10) {
            const bool pre = (((HALF_TOK / 256) * (2 * DFF / 256)) % G) != 0;
            bf16_t* T0 = pre ? (bf16_t*)(ws + WS_PPT) : (bf16_t*)dob; bf16_t* T1 = pre ? (bf16_t*)dob : (bf16_t*)(dob + 32 * MiB);
            { pg8::Gemm g{(const bf16_t*)(ws + WS_PBF), (const bf16_t*)(ws + WS_WPP), NTOK, DM, PLE}; pg8::StaticOrder S; S.init(NTOK, DM, G, bid); if (pre) S.lo = 256;
              EpiPP E{T0, T1}; pg8::gemm_phase(lds, g, S, E); }
            asm volatile("s_waitcnt vmcnt(0)" ::: "memory"); __syncthreads();
            { pg8::Gemm g{(const bf16_t*)(ws + WS_H1B), (const bf16_t*)(ws + WS_WPG), NTOK, DM, DM}; pg8::StaticOrder S; S.init(NTOK, DM, G, bid);
              EpiPG E{T0, T1, (float*)(ws + WS_H1), (const float*)(ws + WS_RSS2), P.in[22], (float*)(ws + WS_RSS3)}; pg8::gemm_phase(lds, g, S, E); } }
        else if (ph == 11) { const float* r3 = (const float*)(ws + WS_RSS3); const float* fw = P.in[23]; const f32x4* h3 = (const f32x4*)(ws + WS_H1);
            const int nchunk = NTOK * DM / 4 / 1024; const int wv = bid * 8 + (tid >> 6), lane = tid & 63;
            for (int ck = wv; ck < nchunk; ck += G * 8) { f32x4 v[16];
#pragma unroll
                for (int j = 0; j < 16; ++j) v[j] = __builtin_nontemporal_load(h3 + (ck * 16 + j) * 64 + lane);
#pragma unroll
                for (int j = 0; j < 16; ++j) { const int i = (ck * 16 + j) * 64 + lane; const int row = i >> 8, c4 = i & 255; const float rstd = rsqrtf(r3[row] * (1.0f / DM) + 1e-6f);
                    __builtin_nontemporal_store(v[j] * rstd * *(const f32x4*)(fw + 4 * c4), (f32x4*)P.out + i); } } }
        if (ph < ph_hi) {
            if (ph_lo < 0) grid.sync();
            xcd_barrier(xb);
        }
    }
}

extern "C" void kernel_launch(void* const* d_in, const int* in_sizes, int n_in, void* d_out, int out_size, void* d_ws, size_t ws_size, hipStream_t stream) {
    static int grid_blocks = 0;
    if (!grid_blocks) {
        int dev = 0, cus = 0, per_cu = 0;
        hipGetDevice(&dev);
        hipDeviceGetAttribute(&cus, hipDeviceAttributeMultiprocessorCount, dev);
        if (hipFuncSetAttribute((const void*)mega, hipFuncAttributeMaxDynamicSharedMemorySize, LDS_BYTES) != hipSuccess) { fprintf(stderr, "hipFuncSetAttribute failed\n"); }
        hipOccupancyMaxActiveBlocksPerMultiprocessor(&per_cu, (const void*)mega, 512, LDS_BYTES);
        if (per_cu < 1) per_cu = 1;
        grid_blocks = cus * 1;
        (void)hipGetLastError();
    }
    if (n_in < 24 || ws_size < 248 * MiB) { fprintf(stderr, "kernel_launch: unexpected inputs / workspace\n"); return; }
    Params p{};
    for (int i = 0; i < 24; ++i) p.in[i] = (const float*)d_in[i];
    p.out = (float*)d_out; p.ws = (unsigned char*)d_ws; p.ph_lo = 0; p.ph_hi = 11;
    if (hipMemsetAsync((char*)d_out + DO_BAR, 0, XCD_BAR_WORDS * 4, stream) != hipSuccess) { fprintf(stderr, "memset failed\n"); return; }
    void* args[] = {&p};
    hipError_t e = hipLaunchCooperativeKernel((const void*)mega, dim3(grid_blocks), dim3(512), args, LDS_BYTES, stream);
    if (e != hipSuccess) fprintf(stderr, "cooperative launch failed: %s (grid %d)\n", hipGetErrorString(e), grid_blocks);
}
```

```cpp
#include <hip/hip_runtime.h>
#include <hip/hip_cooperative_groups.h>
#include <cstdio>
namespace cg = cooperative_groups;

#define LAS __attribute__((address_space(3)))
typedef unsigned short bf16_t;
typedef short bf16x8 __attribute__((ext_vector_type(8)));
typedef short s16x4 __attribute__((ext_vector_type(4)));
typedef float f32x4 __attribute__((ext_vector_type(4)));
typedef float f32x2 __attribute__((ext_vector_type(2)));
typedef unsigned u32x4 __attribute__((ext_vector_type(4)));
typedef unsigned u32x2 __attribute__((ext_vector_type(2)));

constexpr int NTOK = 32768, DM = 1024, NPROJ = 4096, INCOLS = 4112, DFF = 2816, PLE = 256, HALF_TOK = 16384;
constexpr size_t MiB = 1024ull * 1024ull;
constexpr size_t WS_PROJ = 0, WS_H1 = 0, WS_H1B = 128 * MiB, WS_PBF = 192 * MiB, WS_WPG = 208 * MiB, WS_WPP = 210 * MiB,
                 WS_RSS2 = 211 * MiB, WS_RSS3 = 211 * MiB + 128 * 1024, WS_GH = 212 * MiB, WS_BAR = 214 * MiB, WS_PPT = 216 * MiB;
constexpr size_t DO_ABF = 0, DO_MIXED = 0, DO_GATES = 64 * MiB, DO_ROPE = 66 * MiB, DO_TOT = 70 * MiB, DO_TOTS = 95 * MiB,
                 DO_RSS1 = 99 * MiB + 256 * 1024, DO_W1T = 100 * MiB, DO_WOT = 108 * MiB, DO_WGT = 110 * MiB, DO_WUT = 110 * MiB + 5632 * 1024,
                 DO_WDT = 121 * MiB, DO_G = 0, DO_GR = 88 * MiB, DO_UP = 93 * MiB + 512 * 1024, DO_HQ = 95 * MiB + 64 * 1024, DO_BAR = 99 * MiB + 512 * 1024;
constexpr int LDS_BYTES = 155648;
constexpr int NSLOT = 352;

struct Params { const float* in[24]; float* out; unsigned char* ws; int ph_lo, ph_hi; };

#define NTL(p) __builtin_nontemporal_load((const f32x4*)(p))
#define NTS(v, p) __builtin_nontemporal_store((v), (f32x4*)(p))
__device__ __forceinline__ unsigned cvt_pk_bf16(float lo, float hi) { unsigned r; asm volatile("v_cvt_pk_bf16_f32 %0, %1, %2" : "=v"(r) : "v"(lo), "v"(hi)); return r; }
__device__ __forceinline__ float bf_lo(unsigned w) { return __uint_as_float(w << 16); }
__device__ __forceinline__ float bf_hi(unsigned w) { return __uint_as_float(w & 0xffff0000u); }
__device__ __forceinline__ float sigmoidf_(float x) { return 1.0f / (1.0f + __expf(-x)); }
__device__ __forceinline__ float logsigmoidf_(float x) { return fminf(x, 0.0f) - log1pf(__expf(-fabsf(x))); }
__device__ __forceinline__ f32x2 gelu_pk(f32x2 v) {
    const f32x2 av = __builtin_elementwise_abs(v), d = av * 0.2316418882f + 1.0f;
    f32x2 t; t.x = __builtin_amdgcn_rcpf(d.x); t.y = __builtin_amdgcn_rcpf(d.y);
    f32x2 q = t * 0.5307027145f + (-0.7265760135f); q = q * t + 0.7107068705f; q = q * t + (-0.142248368f); q = q * t + 0.127414796f; q = q * t;
    const f32x2 s = (v * v) * (-0.72134752044f);
    f32x2 e; e.x = __builtin_amdgcn_exp2f(s.x); e.y = __builtin_amdgcn_exp2f(s.y);
    const f32x2 m = v * (q * e), r = v - m;
    f32x2 o; o.x = v.x < 0.f ? m.x : r.x; o.y = v.y < 0.f ? m.y : r.y; return o;
}
__device__ __forceinline__ const float* xrow(const Params& P, int t) { return t < HALF_TOK ? P.in[0] + (size_t)t * DM : P.in[1] + (size_t)(t - HALF_TOK) * DM; }
__device__ __forceinline__ const float* prow(const Params& P, int t) { return t < HALF_TOK ? P.in[2] + (size_t)t * PLE : P.in[3] + (size_t)(t - HALF_TOK) * PLE; }

namespace pg8 {
constexpr int BM = 256, BK = 64, HALF = 128, HTB = HALF * BK * 2, STAGE_BYTES = 8 * HTB, NXCD = 8, WGM = 8;
__device__ __forceinline__ int lds_byte(int r, int c) { const int st = (r >> 4) * 2 + (c >> 5), rr = r & 15, cc = c & 31, ob = rr * 64 + cc * 2; return st * 1024 + (ob ^ (((ob >> 9) & 1) << 5)); }
__device__ __forceinline__ void stage_rc(int b, int& R, int& C) { const int st = b / 1024, sb = b % 1024, swz = sb ^ (((sb >> 9) & 1) << 5); R = (st >> 1) * 16 + swz / 64; C = (st & 1) * 32 + (swz % 64) / 2; }
__device__ __forceinline__ int perm32(int rho) { const int n = rho >> 4, i = rho & 15; return 8 * (i >> 2) + 4 * n + (i & 3); }
struct Unit { int pm, pn, L; };
struct Gemm { const bf16_t* A; const bf16_t* Bt; int M, N, K; };
struct StaticOrder {
    int nM, nN, nwg, G, c, lo, hi;
    __device__ void init(int M, int N, int G_, int c_) { nM = M / BM; nN = N / BM; nwg = nM * nN; G = G_; c = c_; lo = 0; hi = nwg; }
    __device__ bool next(int i, Unit& u) const {
        const long L = (long)lo + (long)i * G + c; if (L >= hi) return false; u.L = (int)L;
        int wgid = (int)L; { const int q = nwg / NXCD, r = nwg % NXCD, xcd = wgid % NXCD, off = wgid / NXCD; wgid = (xcd < r ? xcd * (q + 1) : r * (q + 1) + (xcd - r) * q) + off; }
        const int nig = WGM * nN, gid = wgid / nig, fm = gid * WGM, gsz = (nM - fm) < WGM ? (nM - fm) : WGM;
        u.pm = fm + ((wgid % nig) % gsz); u.pn = (wgid % nig) / gsz; return true;
    }
};
template <class Epi>
__device__ __forceinline__ void gemm_phase(LAS unsigned char* lds, const Gemm g, const StaticOrder& S, const Epi& E) {
    int tid = threadIdx.x; asm volatile("" : "+v"(tid));
    const int wid = __builtin_amdgcn_readfirstlane(tid >> 6), lane = tid & 63, wr = wid >> 2, wc = wid & 3, fr = lane & 15, fq = lane >> 4;
    int K = g.K; asm volatile("" : "+s"(K));
    const int nt = K / BK;
    unsigned voffA[2], voffB[2];
#pragma unroll
    for (int i = 0; i < 2; ++i) { int R, C; stage_rc(tid * 16 + i * 8192, R, C); const int Rb = (R & ~31) + perm32(R & 31);
        voffA[i] = (unsigned)(R * K + C) * 2u; voffB[i] = (unsigned)(Rb * K + C) * 2u; }
    const size_t kstep = (size_t)(BK * 2);
    const size_t hstep = (size_t)HALF * K * 2;
    const size_t tstep = 2 * hstep;
    const unsigned ldsw = (unsigned)wid * 1024u;
    const int aoff = lds_byte(wr * 64 + fr, fq * 8), boff = lds_byte(wc * 32 + fr, fq * 8);
#define PG8_SA(b, h) (((b) * 2 + (h)) * HTB)
#define PG8_SB(b, h) ((4 + (b) * 2 + (h)) * HTB)
#define PG8_STAGE(bufoff, gbase, voff) do { _Pragma("unroll") for (int _i = 0; _i < 2; ++_i) \
        __builtin_amdgcn_global_load_lds((const unsigned*)((const char*)(gbase) + (voff)[_i]), (LAS unsigned*)(lds + (bufoff) + ldsw + _i * 8192), 16, 0, 0); } while (0)
#define PG8_LDA(dst, b, h) do { _Pragma("unroll") for (int m = 0; m < 4; ++m) _Pragma("unroll") for (int k = 0; k < 2; ++k) dst[m][k] = *(const LAS bf16x8*)(lds + PG8_SA(b, h) + aoff + m * 2048 + k * 1024); } while (0)
#define PG8_LDB(dst, b, h) do { _Pragma("unroll") for (int n = 0; n < 2; ++n) _Pragma("unroll") for (int k = 0; k < 2; ++k) dst[n][k] = *(const LAS bf16x8*)(lds + PG8_SB(b, h) + boff + n * 2048 + k * 1024); } while (0)
#define PG8_MMA(ai, bj, At, Bt) do { __builtin_amdgcn_s_setprio(1); _Pragma("unroll") for (int m = 0; m < 4; ++m) _Pragma("unroll") for (int n = 0; n < 2; ++n) _Pragma("unroll") for (int k = 0; k < 2; ++k) \
        acc[ai][bj][m][n] = __builtin_amdgcn_mfma_f32_16x16x32_bf16(Bt[n][k], At[m][k], acc[ai][bj][m][n], 0, 0, 0); __builtin_amdgcn_s_setprio(0); } while (0)
#define PG8_WAIT_V(n) asm volatile("s_waitcnt vmcnt(" #n ")" ::: "memory")
#define PG8_WAIT_L(n) asm volatile("s_waitcnt lgkmcnt(" #n ")" ::: "memory")
#define PG8_BAR __builtin_amdgcn_s_barrier()
#define PG8_SCHED __builtin_amdgcn_sched_barrier(0)
    Unit cur, nxt; int ui = 0;
    if (!S.next(0, cur)) return;
    f32x4 acc[2][2][4][2];
#pragma unroll
    for (int a = 0; a < 2; ++a)
#pragma unroll
        for (int b = 0; b < 2; ++b)
#pragma unroll
            for (int m = 0; m < 4; ++m)
#pragma unroll
                for (int n = 0; n < 2; ++n) acc[a][b][m][n] = (f32x4){0.f, 0.f, 0.f, 0.f};
    bf16x8 At[4][2], B0[2][2], B1[2][2];
    const char* cA = (const char*)g.A + (size_t)cur.pm * tstep; const char* cB = (const char*)g.Bt + (size_t)cur.pn * tstep;
    PG8_STAGE(PG8_SB(0, 0), cB, voffB); PG8_STAGE(PG8_SA(0, 0), cA, voffA); PG8_STAGE(PG8_SB(0, 1), cB + hstep, voffB); PG8_STAGE(PG8_SA(0, 1), cA + hstep, voffA);
    if (wr == 1) PG8_BAR;
    PG8_WAIT_V(4); PG8_BAR;
    PG8_STAGE(PG8_SB(1, 0), cB + kstep, voffB); PG8_STAGE(PG8_SA(1, 0), cA + kstep, voffA); PG8_STAGE(PG8_SB(1, 1), cB + hstep + kstep, voffB);
    PG8_WAIT_V(6); PG8_BAR;
    for (;;) {
        const bool has_next = S.next(ui + 1, nxt);
        const char* nA = has_next ? (const char*)g.A + (size_t)nxt.pm * tstep : cA; const char* nB = has_next ? (const char*)g.Bt + (size_t)nxt.pn * tstep : cB;
        for (int t = 0; t < nt; t += 2) {
            const bool last = (t == nt - 2);
            const char* a1 = cA + (size_t)(t + 1) * kstep;
            const char* a2 = last ? nA : cA + (size_t)(t + 2) * kstep; const char* b2 = last ? nB : cB + (size_t)(t + 2) * kstep;
            const char* a3 = a2 + kstep; const char* b3 = b2 + kstep;
            PG8_LDB(B0, 0, 0); PG8_SCHED; PG8_LDA(At, 0, 0); PG8_STAGE(PG8_SA(1, 1), a1 + hstep, voffA);
            PG8_WAIT_L(8); PG8_BAR; PG8_WAIT_L(0); PG8_MMA(0, 0, At, B0); PG8_BAR; PG8_SCHED;
            PG8_LDB(B1, 0, 1); PG8_STAGE(PG8_SB(0, 0), b2, voffB);
            PG8_BAR; PG8_WAIT_L(0); PG8_MMA(0, 1, At, B1); PG8_BAR;
            PG8_LDA(At, 0, 1); PG8_STAGE(PG8_SA(0, 0), a2, voffA);
            PG8_BAR; PG8_WAIT_L(0); PG8_MMA(1, 0, At, B0); PG8_BAR; PG8_SCHED;
            PG8_STAGE(PG8_SB(0, 1), b2 + hstep, voffB);
            PG8_WAIT_V(6); PG8_BAR; PG8_MMA(1, 1, At, B1); PG8_BAR;
            PG8_LDB(B0, 1, 0); PG8_SCHED; PG8_LDA(At, 1, 0); PG8_STAGE(PG8_SA(0, 1), a2 + hstep, voffA);
            PG8_WAIT_L(8); PG8_BAR; PG8_WAIT_L(0); PG8_MMA(0, 0, At, B0); PG8_BAR; PG8_SCHED;
            PG8_LDB(B1, 1, 1); PG8_STAGE(PG8_SB(1, 0), b3, voffB);
            PG8_BAR; PG8_WAIT_L(0); PG8_MMA(0, 1, At, B1); PG8_BAR;
            PG8_LDA(At, 1, 1); PG8_STAGE(PG8_SA(1, 0), a3, voffA);
            PG8_BAR; PG8_WAIT_L(0); PG8_MMA(1, 0, At, B0); PG8_BAR; PG8_SCHED;
            PG8_STAGE(PG8_SB(1, 1), b3 + hstep, voffB);
            PG8_WAIT_V(6); PG8_BAR; PG8_MMA(1, 1, At, B1); PG8_BAR;
        }
        E(acc, cur, wr, wc, fr, fq);
        if (!has_next) break;
#pragma unroll
        for (int a = 0; a < 2; ++a)
#pragma unroll
            for (int b = 0; b < 2; ++b)
#pragma unroll
                for (int m = 0; m < 4; ++m)
#pragma unroll
                    for (int n = 0; n < 2; ++n) acc[a][b][m][n] = (f32x4){0.f, 0.f, 0.f, 0.f};
        cur = nxt; cA = nA; cB = nB; ++ui;
    }
    PG8_WAIT_V(0);
    if (wr == 0) PG8_BAR;
    PG8_BAR;
#undef PG8_SA
#undef PG8_SB
#undef PG8_STAGE
#undef PG8_LDA
#undef PG8_LDB
#undef PG8_MMA
#undef PG8_WAIT_V
#undef PG8_WAIT_L
#undef PG8_BAR
#undef PG8_SCHED
}
}
using pg8::Unit;
typedef f32x4 AccT[2][2][4][2];

__device__ __forceinline__ unsigned dpp_prev(unsigned cur, unsigned below) {
    const int t = __builtin_amdgcn_update_dpp(0, (int)below, 0x121  , 0xf, 0xf, false);
    return (unsigned)__builtin_amdgcn_update_dpp(t, (int)cur, 0x111  , 0xf, 0xf, false);
}
__device__ __forceinline__ unsigned dpp_next(unsigned cur, unsigned above) {
    const int t = __builtin_amdgcn_update_dpp(0, (int)above, 0x12F  , 0xf, 0xf, false);
    return (unsigned)__builtin_amdgcn_update_dpp(t, (int)cur, 0x101  , 0xf, 0xf, false);
}
__device__ __forceinline__ float dppf_prev(float cur, float below) { return __uint_as_float(dpp_prev(__float_as_uint(cur), __float_as_uint(below))); }
__device__ __forceinline__ float dppf_next(float cur, float above) { return __uint_as_float(dpp_next(__float_as_uint(cur), __float_as_uint(above))); }
struct EpiProj {
    bf16_t* O; const f32x2* rope; bf16_t* HQ; const float* cw; const float* cb;
    __device__ __forceinline__ void operator()(AccT& acc, const Unit& u, int wr, int wc, int fr, int fq) const {
        asm volatile("" : "+v"(fr)); asm volatile("" : "+v"(fq));
        const int row0 = u.pm * 256 + wr * 64 + fr, col0 = u.pn * 256 + wc * 32 + 8 * fq;
        const bool rot = u.pn < 4, mqk = (u.pn >= 8 && u.pn < 12);
        const int i0 = 16 * wc + 4 * fq;
        if (mqk) {
            const int mc0 = col0 - 2048;
#pragma unroll
            for (int ai = 0; ai < 2; ++ai) { const int grp = u.pm * 4 + ai * 2 + wr;
#pragma unroll
                for (int bj = 0; bj < 2; ++bj) { const int mc = mc0 + bj * 128; const float mul = mc < 512 ? 0.08838834764831845f : 1.0f;
#pragma unroll
                    for (int n = 0; n < 2; ++n) {
                        const f32x4 w0 = *(const f32x4*)(cw + mc + 4 * n), w1 = *(const f32x4*)(cw + 1024 + mc + 4 * n), w2 = *(const f32x4*)(cw + 2048 + mc + 4 * n), b = *(const f32x4*)(cb + mc + 4 * n);
#pragma unroll
                        for (int m = 0; m < 4; ++m) { const int lr = m * 16 + fr; const f32x4 gc = acc[ai][bj][m][n]; f32x4 o;
#pragma unroll
                            for (int j = 0; j < 4; ++j) { const float gp = dppf_prev(gc[j], m > 0 ? acc[ai][bj][m - 1][n][j] : 0.f), gn = dppf_next(gc[j], m < 3 ? acc[ai][bj][m + 1][n][j] : 0.f);
                                const float uu = gp * w0[j] + gc[j] * w1[j] + gn * w2[j] + b[j]; o[j] = uu * sigmoidf_(uu) * mul; }
                            u32x2 w; w.x = cvt_pk_bf16(o[0], o[1]); w.y = cvt_pk_bf16(o[2], o[3]);
                            *(u32x2*)(O + (size_t)(grp * 64 + lr) * NPROJ + col0 + bj * 128 + 4 * n) = w;
                            if (m == 0 || m == 3) { if (lr < 2 || lr > 61) { u32x2 wg; wg.x = cvt_pk_bf16(gc[0], gc[1]); wg.y = cvt_pk_bf16(gc[2], gc[3]);
                                *(u32x2*)(HQ + (size_t)(grp * 4 + (lr < 2 ? lr : lr - 60)) * 1024 + mc + 4 * n) = wg; } } } } } }
            return; }
#pragma unroll
        for (int ai = 0; ai < 2; ++ai)
#pragma unroll
            for (int m = 0; m < 4; ++m) { const int row = row0 + ai * 128 + m * 16; bf16_t* rowp = O + (size_t)row * NPROJ + col0;
                f32x4 cs0 = (f32x4){1.f, 0.f, 1.f, 0.f}, cs1 = cs0;
                if (rot) { const int pos = row < HALF_TOK ? (row & 8191) : ((row - HALF_TOK) & 2047); const f32x2* rp = rope + (size_t)pos * 64 + i0; cs0 = *(const f32x4*)rp; cs1 = *(const f32x4*)(rp + 2); }
#pragma unroll
                for (int bj = 0; bj < 2; ++bj) { f32x4 v0 = acc[ai][bj][m][0], v1 = acc[ai][bj][m][1];
                    if (rot) { const f32x4 a = v0, b = v1;
                        v0[0] = a[0] * cs0[0] - a[1] * cs0[1]; v0[1] = a[1] * cs0[0] + a[0] * cs0[1]; v0[2] = a[2] * cs0[2] - a[3] * cs0[3]; v0[3] = a[3] * cs0[2] + a[2] * cs0[3];
                        v1[0] = b[0] * cs1[0] - b[1] * cs1[1]; v1[1] = b[1] * cs1[0] + b[0] * cs1[1]; v1[2] = b[2] * cs1[2] - b[3] * cs1[3]; v1[3] = b[3] * cs1[2] + b[2] * cs1[3]; }
                    u32x4 w; w.x = cvt_pk_bf16(v0[0], v0[1]); w.y = cvt_pk_bf16(v0[2], v0[3]); w.z = cvt_pk_bf16(v1[0], v1[1]); w.w = cvt_pk_bf16(v1[2], v1[3]);
                    *(u32x4*)(rowp + bj * 128) = w; }
                __builtin_amdgcn_sched_barrier(0); }
    }
};
struct EpiG2 {
    const float* x0; const float* x1; float* H; bf16_t* HB; float* rss;
    __device__ __forceinline__ void operator()(AccT& acc, const Unit& u, int wr, int wc, int fr, int fq) const {
        asm volatile("" : "+v"(fr)); asm volatile("" : "+v"(fq));
        const int row0 = u.pm * 256 + wr * 64 + fr, col0 = u.pn * 256 + wc * 32 + 8 * fq;
        f32x4 xv[2][4];
        { const int row = row0; const float* xr = (row < HALF_TOK ? x0 + (size_t)row * DM : x1 + (size_t)(row - HALF_TOK) * DM) + col0;
          xv[0][0] = NTL(xr); xv[0][1] = NTL(xr + 4); xv[0][2] = NTL(xr + 128); xv[0][3] = NTL(xr + 132); }
#pragma unroll
        for (int r = 0; r < 8; ++r) { const int ai = r >> 2, m = r & 3; const int row = row0 + ai * 128 + m * 16;
            if (r < 7) { const int rn = row0 + ((r + 1) >> 2) * 128 + ((r + 1) & 3) * 16; const float* xr = (rn < HALF_TOK ? x0 + (size_t)rn * DM : x1 + (size_t)(rn - HALF_TOK) * DM) + col0;
                xv[(r + 1) & 1][0] = NTL(xr); xv[(r + 1) & 1][1] = NTL(xr + 4); xv[(r + 1) & 1][2] = NTL(xr + 128); xv[(r + 1) & 1][3] = NTL(xr + 132); }
            float* hr = H + (size_t)row * DM + col0; float ss = 0.f;
#pragma unroll
            for (int bj = 0; bj < 2; ++bj) {
                f32x4 v0 = acc[ai][bj][m][0] + xv[r & 1][2 * bj], v1 = acc[ai][bj][m][1] + xv[r & 1][2 * bj + 1];
                NTS(v0, hr + bj * 128); NTS(v1, hr + bj * 128 + 4);
                u32x4 w; w.x = cvt_pk_bf16(v0[0], v0[1]); w.y = cvt_pk_bf16(v0[2], v0[3]); w.z = cvt_pk_bf16(v1[0], v1[1]); w.w = cvt_pk_bf16(v1[2], v1[3]);
                *(u32x4*)(HB + (size_t)row * DM + col0 + bj * 128) = w;
#pragma unroll
                for (int j = 0; j < 4; ++j) ss += v0[j] * v0[j] + v1[j] * v1[j]; }
            ss += __shfl_xor(ss, 16); ss += __shfl_xor(ss, 32);
            if (fq == 0) unsafeAtomicAdd(rss + row, ss); __builtin_amdgcn_sched_barrier(0); }
    }
};
struct EpiF12 {
    bf16_t* ACT; bf16_t* GR; bf16_t* UP; const float* rss; const float* cw; const float* cb; int half;
    __device__ __forceinline__ void operator()(AccT& acc, const Unit& u, int wr, int wc, int fr, int fq) const {
        asm volatile("" : "+v"(fr)); asm volatile("" : "+v"(fq));
        const int fcol = u.pn * 128 + wc * 32 + 8 * fq;
#pragma unroll
        for (int ai = 0; ai < 2; ++ai) { const int gidx = u.pm * 4 + ai * 2 + wr;
#pragma unroll
            for (int m = 0; m < 4; ++m) { const float rstd = rsqrtf(rss[half * HALF_TOK + gidx * 64 + m * 16 + fr] * (1.0f / DM) + 1e-6f);
#pragma unroll
                for (int n = 0; n < 2; ++n) { acc[ai][0][m][n] = acc[ai][0][m][n] * rstd; acc[ai][1][m][n] = acc[ai][1][m][n] * rstd; } }
#pragma unroll
            for (int n = 0; n < 2; ++n) {
                const f32x4 w0 = *(const f32x4*)(cw + fcol + 4 * n), w1 = *(const f32x4*)(cw + DFF + fcol + 4 * n), w2 = *(const f32x4*)(cw + 2 * DFF + fcol + 4 * n), b = *(const f32x4*)(cb + fcol + 4 * n);
#pragma unroll
                for (int m = 0; m < 4; ++m) { const int lr = m * 16 + fr;
                    const f32x4 gc = acc[ai][0][m][n], up = acc[ai][1][m][n]; f32x4 uu;
#pragma unroll
                    for (int j = 0; j < 4; ++j) { const float gp = dppf_prev(gc[j], m > 0 ? acc[ai][0][m - 1][n][j] : 0.f), gn = dppf_next(gc[j], m < 3 ? acc[ai][0][m + 1][n][j] : 0.f);
                        uu[j] = gp * w0[j] + gc[j] * w1[j] + gn * w2[j] + b[j]; }
                    const f32x2 ga = gelu_pk((f32x2){uu[0], uu[1]}), gb = gelu_pk((f32x2){uu[2], uu[3]});
                    u32x2 wa; wa.x = cvt_pk_bf16(ga.x * up[0], ga.y * up[1]); wa.y = cvt_pk_bf16(gb.x * up[2], gb.y * up[3]);
                    *(u32x2*)(ACT + (size_t)(gidx * 64 + lr) * DFF + fcol + 4 * n) = wa;
                    if (m == 0 || m == 3) {
                        if (lr == 0 || lr == 63) { u32x2 wu; wu.x = cvt_pk_bf16(up[0], up[1]); wu.y = cvt_pk_bf16(up[2], up[3]); *(u32x2*)(UP + (size_t)(gidx * 2 + (lr == 63 ? 1 : 0)) * DFF + fcol + 4 * n) = wu; }
                        if (lr < 2 || lr > 61) { u32x2 wg; wg.x = cvt_pk_bf16(gc[0], gc[1]); wg.y = cvt_pk_bf16(gc[2], gc[3]); *(u32x2*)(GR + (size_t)(gidx * 4 + (lr < 2 ? lr : lr - 60)) * DFF + fcol + 4 * n) = wg; } } } }
        }
    }
};
__device__ void ffn_fix(bf16_t* ACT, const bf16_t* GR, const bf16_t* UP, const float* cw, const float* cb, int pm, int half) {
    int tid = threadIdx.x; asm volatile("" : "+v"(tid));
    const int seqgroups = half ? 32 : 128;
    for (int it = tid; it < 8 * 352; it += 512) { const int br = it / 352, col = (it % 352) * 8; const int group = pm * 4 + (br >> 1), which = br & 1;
        const bool seq_first = (group % seqgroups) == 0, seq_last = (group % seqgroups) == seqgroups - 1;
        const bf16_t* pp = which ? GR + (size_t)(group * 4 + 2) * DFF : GR + (size_t)((seq_first ? group : group - 1) * 4 + 3) * DFF;
        const bf16_t* pc = GR + (size_t)(group * 4 + (which ? 3 : 0)) * DFF;
        const bf16_t* pn = which ? GR + (size_t)((seq_last ? group : group + 1) * 4 + 0) * DFF : GR + (size_t)(group * 4 + 1) * DFF;
        const float mp = (!which && seq_first) ? 0.f : 1.f, mn = (which && seq_last) ? 0.f : 1.f;
        const u32x4 gp = *(const u32x4*)(pp + col), gc = *(const u32x4*)(pc + col), gn = *(const u32x4*)(pn + col), up = *(const u32x4*)(UP + (size_t)(group * 2 + which) * DFF + col);
        u32x4 ov;
#pragma unroll
        for (int q = 0; q < 4; ++q) { const int c = col + 2 * q;
            const float u0 = bf_lo(gp[q]) * mp * cw[c] + bf_lo(gc[q]) * cw[DFF + c] + bf_lo(gn[q]) * mn * cw[2 * DFF + c] + cb[c];
            const float u1 = bf_hi(gp[q]) * mp * cw[c + 1] + bf_hi(gc[q]) * cw[DFF + c + 1] + bf_hi(gn[q]) * mn * cw[2 * DFF + c + 1] + cb[c + 1];
            const f32x2 ge = gelu_pk((f32x2){u0, u1}); ov[q] = cvt_pk_bf16(ge.x * bf_lo(up[q]), ge.y * bf_hi(up[q])); }
        *(u32x4*)(ACT + (size_t)(group * 64 + (which ? 63 : 0)) * DFF + col) = ov; }
    asm volatile("s_waitcnt vmcnt(0)" ::: "memory"); __syncthreads();
}
struct EpiF3 {
    float* H; bf16_t* HB; float* rss; int half;
    __device__ __forceinline__ void operator()(AccT& acc, const Unit& u, int wr, int wc, int fr, int fq) const {
        asm volatile("" : "+v"(fr)); asm volatile("" : "+v"(fq));
        const int row0 = half * HALF_TOK + u.pm * 256 + wr * 64 + fr, col0 = u.pn * 256 + wc * 32 + 8 * fq;
        f32x4 hv[2][4];
        { const float* hr = H + (size_t)row0 * DM + col0; hv[0][0] = NTL(hr); hv[0][1] = NTL(hr + 4); hv[0][2] = NTL(hr + 128); hv[0][3] = NTL(hr + 132); }
#pragma unroll
        for (int r = 0; r < 8; ++r) { const int ai = r >> 2, m = r & 3; const int row = row0 + ai * 128 + m * 16;
            if (r < 7) { const int rn = row0 + ((r + 1) >> 2) * 128 + ((r + 1) & 3) * 16; const float* hn = H + (size_t)rn * DM + col0;
                hv[(r + 1) & 1][0] = NTL(hn); hv[(r + 1) & 1][1] = NTL(hn + 4); hv[(r + 1) & 1][2] = NTL(hn + 128); hv[(r + 1) & 1][3] = NTL(hn + 132); }
            float* hr = H + (size_t)row * DM + col0; float ss = 0.f;
#pragma unroll
            for (int bj = 0; bj < 2; ++bj) {
                f32x4 v0 = acc[ai][bj][m][0] + hv[r & 1][2 * bj], v1 = acc[ai][bj][m][1] + hv[r & 1][2 * bj + 1];
                NTS(v0, hr + bj * 128); NTS(v1, hr + bj * 128 + 4);
                u32x4 w; w.x = cvt_pk_bf16(v0[0], v0[1]); w.y = cvt_pk_bf16(v0[2], v0[3]); w.z = cvt_pk_bf16(v1[0], v1[1]); w.w = cvt_pk_bf16(v1[2], v1[3]);
                *(u32x4*)(HB + (size_t)row * DM + col0 + bj * 128) = w;
#pragma unroll
                for (int j = 0; j < 4; ++j) ss += v0[j] * v0[j] + v1[j] * v1[j]; }
            ss += __shfl_xor(ss, 16); ss += __shfl_xor(ss, 32);
            if (fq == 0) unsafeAtomicAdd(rss + row, ss); __builtin_amdgcn_sched_barrier(0); }
    }
};
struct EpiPP {
    bf16_t* T0; bf16_t* T1;
    __device__ __forceinline__ void operator()(AccT& acc, const Unit& u, int wr, int wc, int fr, int fq) const {
        asm volatile("" : "+v"(fr)); asm volatile("" : "+v"(fq));
        bf16_t* base = (u.L < 256 ? T0 : T1) + (size_t)(u.L & 255) * 65536 + (wr * 64 + fr) * 256 + wc * 32 + 8 * fq;
#pragma unroll
        for (int ai = 0; ai < 2; ++ai)
#pragma unroll
            for (int m = 0; m < 4; ++m) { bf16_t* rowp = base + (ai * 128 + m * 16) * 256;
#pragma unroll
                for (int bj = 0; bj < 2; ++bj) { const f32x4 v0 = acc[ai][bj][m][0], v1 = acc[ai][bj][m][1];
                    u32x4 w; w.x = cvt_pk_bf16(v0[0], v0[1]); w.y = cvt_pk_bf16(v0[2], v0[3]); w.z = cvt_pk_bf16(v1[0], v1[1]); w.w = cvt_pk_bf16(v1[2], v1[3]);
                    *(u32x4*)(rowp + bj * 128) = w; } }
    }
};
struct EpiPG {
    const bf16_t* T0; const bf16_t* T1; float* H; const float* rss2; const float* bias; float* rss3;
    __device__ __forceinline__ void operator()(AccT& acc, const Unit& u, int wr, int wc, int fr, int fq) const {
        asm volatile("" : "+v"(fr)); asm volatile("" : "+v"(fq));
        const int row0 = u.pm * 256 + wr * 64 + fr, col0 = u.pn * 256 + wc * 32 + 8 * fq;
        f32x4 hv[2][4]; u32x4 pv[2][2]; float rs[2];
        const bf16_t* ppbase = (u.L < 256 ? T0 : T1) + (size_t)(u.L & 255) * 65536 + (wr * 64 + fr) * 256 + wc * 32 + 8 * fq;
        { const float* hr = H + (size_t)row0 * DM + col0; const bf16_t* pp = ppbase;
          hv[0][0] = NTL(hr); hv[0][1] = NTL(hr + 4); hv[0][2] = NTL(hr + 128); hv[0][3] = NTL(hr + 132);
          pv[0][0] = *(const u32x4*)pp; pv[0][1] = *(const u32x4*)(pp + 128); rs[0] = rss2[row0]; }
#pragma unroll
        for (int r = 0; r < 8; ++r) { const int ai = r >> 2, m = r & 3; const int row = row0 + ai * 128 + m * 16;
            if (r < 7) { const int rn = row0 + ((r + 1) >> 2) * 128 + ((r + 1) & 3) * 16; const float* hn = H + (size_t)rn * DM + col0; const bf16_t* pn = ppbase + (((r + 1) >> 2) * 128 + ((r + 1) & 3) * 16) * 256;
                hv[(r + 1) & 1][0] = NTL(hn); hv[(r + 1) & 1][1] = NTL(hn + 4); hv[(r + 1) & 1][2] = NTL(hn + 128); hv[(r + 1) & 1][3] = NTL(hn + 132);
                pv[(r + 1) & 1][0] = *(const u32x4*)pn; pv[(r + 1) & 1][1] = *(const u32x4*)(pn + 128); rs[(r + 1) & 1] = rss2[rn]; }
            float* hp = H + (size_t)row * DM + col0; float ss = 0.f; const float rstd = rsqrtf(rs[r & 1] * (1.0f / DM) + 1e-6f);
#pragma unroll
            for (int bj = 0; bj < 2; ++bj) { const u32x4 pw = pv[r & 1][bj];
                const f32x4 b0 = *(const f32x4*)(bias + col0 + bj * 128), b1 = *(const f32x4*)(bias + col0 + bj * 128 + 4);
                const f32x4 p0 = (f32x4){bf_lo(pw.x), bf_hi(pw.x), bf_lo(pw.y), bf_hi(pw.y)}, p1 = (f32x4){bf_lo(pw.z), bf_hi(pw.z), bf_lo(pw.w), bf_hi(pw.w)};
                f32x4 g0 = acc[ai][bj][m][0] * rstd + b0, g1 = acc[ai][bj][m][1] * rstd + b1;
#pragma unroll
                for (int j = 0; j < 4; ++j) { g0[j] = sigmoidf_(g0[j]); g1[j] = sigmoidf_(g1[j]); }
                const f32x4 v0 = hv[r & 1][2 * bj] + p0 * g0, v1 = hv[r & 1][2 * bj + 1] + p1 * g1;
                NTS(v0, hp + bj * 128); NTS(v1, hp + bj * 128 + 4);
#pragma unroll
                for (int j = 0; j < 4; ++j) ss += v0[j] * v0[j] + v1[j] * v1[j]; }
            ss += __shfl_xor(ss, 16); ss += __shfl_xor(ss, 32);
            if (fq == 0) unsafeAtomicAdd(rss3 + row, ss); __builtin_amdgcn_sched_barrier(0); }
    }
};

__device__ void wt_tile(const float* src, int ld, int k0, int n0, bf16_t* dst, int Kdst, const float* kscale, float mul, LAS float* tile, bool rotperm = false, int drow0 = -1) {
    int tid = threadIdx.x; asm volatile("" : "+v"(tid));
    float v[16];
#pragma unroll
    for (int i = 0; i < 16; ++i) { const int k = (tid >> 7) + 4 * i, n = tid & 127; v[i] = src[(size_t)(k0 + k) * ld + n0 + n]; }
#pragma unroll
    for (int i = 0; i < 16; ++i) { const int k = (tid >> 7) + 4 * i, n = tid & 127; float x = v[i] * mul; if (kscale) x *= kscale[k0 + k]; tile[k * 129 + n] = x; }
    __syncthreads();
#pragma unroll
    for (int i = 0; i < 8; ++i) { const int n = (tid >> 5) + 16 * i, k2 = (tid & 31) * 2;
        const float a = tile[k2 * 129 + n], b = tile[(k2 + 1) * 129 + n]; int nn = (drow0 >= 0 ? drow0 : n0) + n; if (rotperm) nn = (nn & ~127) | (2 * (nn & 63) + ((nn >> 6) & 1));
        *(unsigned*)(dst + (size_t)nn * Kdst + k0 + k2) = cvt_pk_bf16(a, b); }
    __syncthreads();
}
__device__ void convert_rest(const Params& P, LAS float* tile, int sub, int nsub) {
    unsigned char* dob = (unsigned char*)P.out;
    const int T2 = 16 * 8, T3 = 16 * 22, T4 = 16 * 22, T5 = 44 * 8, TT = T2 + T3 + T4 + T5;
    for (int t = sub; t < TT; t += nsub) {
        if (t < T2) { const int kt = t & 15, ntl = t >> 4; wt_tile(P.in[12], DM, kt * 64, ntl * 128, (bf16_t*)(dob + DO_WOT), DM, nullptr, 1.0f, tile); }
        else if (t < T2 + T3) { const int u = t - T2, kt = u & 15, ntl = u >> 4; wt_tile(P.in[14], DFF, kt * 64, ntl * 128, (bf16_t*)(dob + DO_WGT), DM, P.in[13], 1.0f, tile, false, ntl * 256); }
        else if (t < T2 + T3 + T4) { const int u = t - T2 - T3, kt = u & 15, ntl = u >> 4; wt_tile(P.in[15], DFF, kt * 64, ntl * 128, (bf16_t*)(dob + DO_WGT), DM, P.in[13], 1.0f, tile, false, ntl * 256 + 128); }
        else { const int u = t - T2 - T3 - T4, kt = u % 44, ntl = u / 44; wt_tile(P.in[18], DM, kt * 64, ntl * 128, (bf16_t*)(dob + DO_WDT), DFF, nullptr, 1.0f, tile); }
    }
}

__device__ void phase0(const Params& P, LAS unsigned char* lds, const int G, const int bid) {
    int tid = threadIdx.x; asm volatile("" : "+v"(tid));
    const int wid = tid >> 6, lane = tid & 63;
    unsigned char* dob = (unsigned char*)P.out;
    { float* r1 = (float*)(dob + DO_RSS1); for (int i = bid * 512 + tid; i < NTOK; i += G * 512) r1[i] = 0.f; }
    { f32x2* rope = (f32x2*)(dob + DO_ROPE);
      for (int i = bid * 512 + tid; i < 8192 * 64; i += G * 512) { const int pos = i >> 6, f = i & 63;
          const float inv = powf(10000.0f, -(float)(2 * f) / 128.0f); const float ang = (float)pos * inv; float s, c; sincosf(ang, &s, &c); rope[i] = (f32x2){c, s}; } }
    { LAS float* tile = (LAS float*)lds;
      for (int t = bid; t < 512; t += G) { const int kt = t & 15, ntl = t >> 4; wt_tile(P.in[5], INCOLS, kt * 64, ntl * 128, (bf16_t*)(dob + DO_W1T), DM, nullptr, ntl < 4 ? 0.08838834764831845f : 1.0f, tile, ntl < 8); } }
    LAS float* wg = (LAS float*)(lds + 40960);
    { const float* win = P.in[5];
#pragma unroll
      for (int i = 0; i < 8; ++i) { const int k = (tid >> 2) + 128 * i, q = tid & 3; const f32x4 v = *(const f32x4*)(win + (size_t)k * INCOLS + NPROJ + 4 * q);
          const int slot = (k & 3) * 256 + (k >> 8) * 64 + ((k >> 2) & 63); *(LAS f32x4*)(wg + slot * 20 + 4 * q) = v; }
      __syncthreads(); }
    { bf16_t* abf = (bf16_t*)(dob + DO_ABF); float* gates = (float*)(dob + DO_GATES);
      const float* nw = P.in[4]; const float* gb = P.in[8];
      f32x4 w4[4];
#pragma unroll
      for (int i = 0; i < 4; ++i) w4[i] = *(const f32x4*)(nw + 4 * lane + 256 * i);
      const int gcol = ((lane >> 5) & 1) * 8 + ((lane >> 4) & 1) * 4 + ((lane >> 3) & 1) * 2 + ((lane >> 2) & 1);
      const float gbias = gb[gcol];
      for (int row0 = bid * 8 + wid; row0 < NTOK; row0 += G * 8 * 4) {
          f32x4 vv[4][4];
#pragma unroll
          for (int rr = 0; rr < 4; ++rr) { const int row = row0 + rr * G * 8; const float* xr = xrow(P, row < NTOK ? row : row0);
#pragma unroll
              for (int i = 0; i < 4; ++i) vv[rr][i] = __builtin_nontemporal_load((const f32x4*)(xr + 4 * lane + 256 * i)); }
#pragma unroll
          for (int rr = 0; rr < 4; ++rr) { const int row = row0 + rr * G * 8; if (row >= NTOK) continue;
              f32x4 (&v)[4] = vv[rr]; float ss = 0.f;
#pragma unroll
              for (int i = 0; i < 4; ++i)
#pragma unroll
                  for (int j = 0; j < 4; ++j) ss += v[i][j] * v[i][j];
#pragma unroll
              for (int o = 32; o >= 1; o >>= 1) ss += __shfl_xor(ss, o);
              const float rstd = rsqrtf(ss * (1.0f / DM) + 1e-6f);
              float ga[16];
#pragma unroll
              for (int c = 0; c < 16; ++c) ga[c] = 0.f;
#pragma unroll
              for (int i = 0; i < 4; ++i) { v[i] = v[i] * rstd * w4[i];
                  u32x2 w; w.x = cvt_pk_bf16(v[i][0], v[i][1]); w.y = cvt_pk_bf16(v[i][2], v[i][3]);
                  *(u32x2*)(abf + (size_t)row * DM + 4 * lane + 256 * i) = w;
#pragma unroll
                  for (int j = 0; j < 4; ++j) { const LAS float* wr_ = wg + (j * 256 + i * 64 + lane) * 20; const float a = v[i][j];
#pragma unroll
                      for (int q = 0; q < 4; ++q) { const f32x4 wv = *(const LAS f32x4*)(wr_ + 4 * q);
                          ga[4 * q] += a * wv[0]; ga[4 * q + 1] += a * wv[1]; ga[4 * q + 2] += a * wv[2]; ga[4 * q + 3] += a * wv[3]; } } }
              float r8[8], r4[4], r2[2], r1;
#pragma unroll
              for (int c = 0; c < 8; ++c) { const bool hi = (lane & 32) != 0; const float send = hi ? ga[c] : ga[c + 8], keep = hi ? ga[c + 8] : ga[c]; r8[c] = keep + __shfl_xor(send, 32); }
#pragma unroll
              for (int c = 0; c < 4; ++c) { const bool hi = (lane & 16) != 0; const float send = hi ? r8[c] : r8[c + 4], keep = hi ? r8[c + 4] : r8[c]; r4[c] = keep + __shfl_xor(send, 16); }
#pragma unroll
              for (int c = 0; c < 2; ++c) { const bool hi = (lane & 8) != 0; const float send = hi ? r4[c] : r4[c + 2], keep = hi ? r4[c + 2] : r4[c]; r2[c] = keep + __shfl_xor(send, 8); }
              { const bool hi = (lane & 4) != 0; const float send = hi ? r2[0] : r2[1], keep = hi ? r2[1] : r2[0]; r1 = keep + __shfl_xor(send, 4); }
              r1 += __shfl_xor(r1, 2); r1 += __shfl_xor(r1, 1);
              if ((lane & 3) == 0) { float gv = r1 + gbias; if (gcol >= 8) gv = logsigmoidf_(gv); gates[(size_t)row * 16 + gcol] = gv; }
          }
      } }
}

__device__ void phase_conv(const Params& P, const int G, const int bid) {
    int tid = threadIdx.x; asm volatile("" : "+v"(tid));
    unsigned char* dob = (unsigned char*)P.out;
    bf16_t* proj = (bf16_t*)(P.ws + WS_PROJ); const bf16_t* HQ = (const bf16_t*)(dob + DO_HQ);
    const float* cw = P.in[6]; const float* cbv = P.in[7];
    for (int it = bid * 512 + tid; it < 512 * 2 * 128; it += G * 512) { const int ch = it & 127, which = (it >> 7) & 1, g = it >> 8; const int col = ch * 8;
        const int gs = g < 256 ? (g & 127) : ((g - 256) & 31), ng = g < 256 ? 128 : 32; const bool seq_first = gs == 0, seq_last = gs == ng - 1;
        const bf16_t* pp = which ? HQ + (size_t)(g * 4 + 2) * 1024 : HQ + (size_t)((seq_first ? g : g - 1) * 4 + 3) * 1024;
        const bf16_t* pc = HQ + (size_t)(g * 4 + (which ? 3 : 0)) * 1024;
        const bf16_t* pn = which ? HQ + (size_t)((seq_last ? g : g + 1) * 4 + 0) * 1024 : HQ + (size_t)(g * 4 + 1) * 1024;
        const float mp = (!which && seq_first) ? 0.f : 1.f, mn = (which && seq_last) ? 0.f : 1.f, mul = col < 512 ? 0.08838834764831845f : 1.0f;
        const u32x4 gp = *(const u32x4*)(pp + col), gc = *(const u32x4*)(pc + col), gn = *(const u32x4*)(pn + col); u32x4 ov;
#pragma unroll
        for (int q = 0; q < 4; ++q) { const int c = col + 2 * q;
            const float u0 = bf_lo(gp[q]) * mp * cw[c] + bf_lo(gc[q]) * cw[1024 + c] + bf_lo(gn[q]) * mn * cw[2048 + c] + cbv[c];
            const float u1 = bf_hi(gp[q]) * mp * cw[c + 1] + bf_hi(gc[q]) * cw[1024 + c + 1] + bf_hi(gn[q]) * mn * cw[2048 + c + 1] + cbv[c + 1];
            ov[q] = cvt_pk_bf16(u0 * sigmoidf_(u0) * mul, u1 * sigmoidf_(u1) * mul); }
        *(u32x4*)(proj + (size_t)(g * 64 + (which ? 63 : 0)) * NPROJ + 2048 + col) = ov; }
}

constexpr unsigned IMG_Q = 0, IMG_K = 32768, IMG_V = 65536, IMG_C = 98304, IMG_VX = 131072, IMG_CX = 135168, VEC0 = 139264;
__device__ __forceinline__ unsigned offb(unsigned row, unsigned ch) { return 256u * row + 16u * (ch ^ (((row & 3u) << 2) | ((row >> 2) & 3u))); }
struct FragB { unsigned rb[4], lp, L16, txb, rp, X16; };
__device__ __forceinline__ void fragb_init(FragB& F, int w, int fr, int fg) {
    const unsigned q = fr >> 2, p = fr & 3, swr = ((fr & 3u) << 2) | ((fr >> 2) & 3u);
#pragma unroll
    for (int s = 0; s < 4; ++s) { unsigned v = 256u * fr + 16u * ((4u * s + fg) ^ swr); asm volatile("" : "+v"(v)); F.rb[s] = v; }
    const unsigned L = (q << 2) | ((fg & 1u) << 1) | (p >> 1);
    F.lp = 256u * (8u * fg + q) + 8u * (p & 1u); F.L16 = 16u * L;
    F.txb = 32u * (8u * fg + q) + 8u * p;
    F.rp = 256u * (16u * w + fr) + 8u * (fg & 1u); F.X16 = 16u * ((fg >> 1) ^ swr);
    asm volatile("" : "+v"(F.lp)); asm volatile("" : "+v"(F.L16)); asm volatile("" : "+v"(F.txb)); asm volatile("" : "+v"(F.rp)); asm volatile("" : "+v"(F.X16));
}
#define ROWFRAG(img, rowbase, s) (*(const LAS bf16x8*)(lds + (img) + 256u * (rowbase) + FB.rb[s]))
__device__ __forceinline__ bf16x8 trfrag_(LAS unsigned char* lds, unsigned a0, unsigned a1) {
    const s16x4 lo = __builtin_amdgcn_ds_read_tr16_b64_v4i16((LAS s16x4*)(lds + a0));
    const s16x4 hi = __builtin_amdgcn_ds_read_tr16_b64_v4i16((LAS s16x4*)(lds + a1));
    return (bf16x8){lo[0], lo[1], lo[2], lo[3], hi[0], hi[1], hi[2], hi[3]};
}
#define TRA(c, t) (FB.lp + (l16 ^ (16u * (2u * (c) + (t)))))
#define TRFRAG(img, c, ks) trfrag_(lds, (img) + 256u * (32u * (ks)) + TRA(c, 0), (img) + 256u * (32u * (ks) + 4u) + TRA(c, 1))
#define TRFRAGX(img, ks) trfrag_(lds, (img) + 32u * (32u * (ks)) + FB.txb, (img) + 32u * (32u * (ks) + 4u) + FB.txb)
#define CWA(nt) (FB.rp + (x16 ^ (32u * (nt))))
#define LAUNDER_L16 unsigned l16 = FB.L16; asm volatile("" : "+v"(l16));
#define LAUNDER_X16 unsigned x16 = FB.X16; asm volatile("" : "+v"(x16));
#define MFMA16(a, b, c) __builtin_amdgcn_mfma_f32_16x16x32_bf16((a), (b), (c), 0, 0, 0)

__device__ void mix_sweep(const Params& P, LAS unsigned char* lds, int tok0, int pos0, int seqlen, int hd, int dir, bool state_only, bool final_pass,
                          f32x4 (&Cacc)[9], float& m_state, float& aseg_sum, float lgam) {
    int tid = threadIdx.x; asm volatile("" : "+v"(tid));
    const int w = __builtin_amdgcn_readfirstlane(tid >> 6), lane = tid & 63, fr = lane & 15, fg = lane >> 4;
    const bool is_m = hd >= 4; const int h = hd & 3;
    unsigned char* dob = (unsigned char*)P.out;
    const bf16_t* proj = (const bf16_t*)(P.ws + WS_PROJ); const float* gates = (const float*)(dob + DO_GATES);
    const f32x2* rope = (const f32x2*)(dob + DO_ROPE); bf16_t* mixed = (bf16_t*)(dob + DO_MIXED);
    LAS float* vrow = (LAS float*)(lds + VEC0); LAS float* vcol = vrow + 128; LAS float* vwi = vrow + 256; LAS float* vkw = vrow + 384; LAS float* vemt = vrow + 512; LAS float* vsc = vrow + 640;
    const int qcol = is_m ? 2048 + h * 128 : h * 128, kcol = is_m ? 2560 + h * 128 : 512 + h * 128, vcolg = is_m ? 3072 + h * 128 : 1024 + h * 128;
    const int gcol = is_m ? 3584 + h * 128 : 1536 + h * 128, mcol = is_m ? 512 + h * 128 : h * 128;
    const float* gnw = (is_m ? P.in[11] : P.in[10]) + h * 128;
    const float LOG2E = 1.4426950408889634f;
    FragB FB; fragb_init(FB, w, fr, fg);
    unsigned ktb0, ktb1; { const unsigned q = fr >> 2, p = fr & 3, L = (q << 2) | ((fg & 1u) << 1) | (p >> 1); ktb0 = 256u * (8u * fg + q) + 8u * (p & 1u) + 16u * (L ^ (2u * w)); ktb1 = 256u * (8u * fg + q) + 8u * (p & 1u) + 16u * (L ^ (2u * w + 1u)); asm volatile("" : "+v"(ktb0)); asm volatile("" : "+v"(ktb1)); }
    __syncthreads();
    if (!state_only) {
#pragma unroll
        for (int nt = 0; nt < 8; ++nt) { u32x2 v; v.x = cvt_pk_bf16(Cacc[nt][0], Cacc[nt][1]); v.y = cvt_pk_bf16(Cacc[nt][2], Cacc[nt][3]);
            { LAUNDER_X16 *(LAS u32x2*)(lds + IMG_C + CWA(nt)) = v; } }
        { u32x2 v; v.x = cvt_pk_bf16(Cacc[8][0], Cacc[8][1]); v.y = cvt_pk_bf16(Cacc[8][2], Cacc[8][3]); *(LAS u32x2*)(lds + IMG_CX + 32 * (16 * w + fr) + 8 * fg) = v; }
    }
    if (tid < 128) { unsigned zz = 0u; asm volatile("" : "+v"(zz)); u32x4 v0 = (u32x4){is_m ? 0x3F80u : zz, zz, zz, zz}; u32x4 z = (u32x4){zz, zz, zz, zz}; *(LAS u32x4*)(lds + IMG_VX + 32 * tid) = v0; *(LAS u32x4*)(lds + IMG_VX + 32 * tid + 16) = z; }
    LAS float* PV = (LAS float*)(lds + 141888); LAS float* PS = PV + 8 * 3 * 128;
    if (is_m) { const int c = dir ? 7 - w : w; const int tokc = tok0 + c * 128;
        const int u0 = 2 * lane, u1 = 2 * lane + 1; const int j0 = dir ? 127 - u0 : u0, j1 = dir ? 127 - u1 : u1;
        const float x0 = gates[(size_t)(tokc + j0) * 16 + 8 + dir * 4 + h], x1 = gates[(size_t)(tokc + j1) * 16 + 8 + dir * 4 + h];
        const float i0 = gates[(size_t)(tokc + j0) * 16 + dir * 4 + h], i1 = gates[(size_t)(tokc + j1) * 16 + dir * 4 + h];
        const float ps = x0 + x1; float sc = ps;
#pragma unroll
        for (int o = 1; o < 64; o <<= 1) { const float t = __shfl_up(sc, o); if (lane >= o) sc += t; }
        const float excl = sc - ps, A0 = excl + x0, A1 = excl + ps, Atot = __shfl(sc, 63);
        const float b0 = i0 - A0, b1 = i1 - A1; const float pm = fmaxf(b0, b1); float scm = pm;
#pragma unroll
        for (int o = 1; o < 64; o <<= 1) { const float t = __shfl_up(scm, o); if (lane >= o) scm = fmaxf(scm, t); }
        float exm = __shfl_up(scm, 1); if (lane == 0) exm = -3.0e38f;
        const float rb0 = fmaxf(exm, b0), rb1 = fmaxf(rb0, b1), bmax = __shfl(scm, 63);
        LAS float* pv = PV + w * 384;
        pv[j0] = A0; pv[j1] = A1; pv[128 + j0] = b0; pv[128 + j1] = b1; pv[256 + j0] = rb0; pv[256 + j1] = rb1;
        if (lane == 0) { PS[2 * w] = Atot; PS[2 * w + 1] = bmax; }
    } else if (tid < 128) { const int j = tid, u = dir ? 127 - j : j; const float A = (float)(u + 1) * lgam, Atot = 128.0f * lgam;
        vrow[j] = A * LOG2E; vcol[j] = -A * LOG2E; vwi[j] = __expf(A); vkw[j] = __expf(Atot - A); vemt[j] = 1.f; if (j == 0) vsc[0] = __expf(Atot); }
    u32x4 t[3][4];
    { const int c = dir ? 7 : 0; const int tok = tok0 + c * 128;
#pragma unroll
      for (int which = 1; which < 3; ++which) { const int cb = which == 0 ? qcol : (which == 1 ? kcol : vcolg);
#pragma unroll
          for (int it = 0; it < 4; ++it) { const int item = tid + 512 * it, r = item >> 4, ch = item & 15; t[which][it] = *(const u32x4*)(proj + (size_t)(tok + r) * NPROJ + cb + 8 * ch); } } }
    for (int ci = 0; ci < 8; ++ci) {
        const int c = dir ? 7 - ci : ci; const int tok = tok0 + c * 128;
        __syncthreads();
        int tl = tid; asm volatile("" : "+v"(tl));
        if (!state_only) {
#pragma unroll
            for (int it = 0; it < 4; ++it) { const int item = tl + 512 * it, r = item >> 4, ch = item & 15; t[0][it] = *(const u32x4*)(proj + (size_t)(tok + r) * NPROJ + qcol + 8 * ch); } }
#pragma unroll
        for (int which = 2; which >= 0; --which) { if (which == 0 && state_only) continue; LAS unsigned char* img = lds + (which == 0 ? IMG_Q : (which == 1 ? IMG_K : IMG_V));
#pragma unroll
            for (int it = 0; it < 4; ++it) { const int item = tl + 512 * it, r = item >> 4, ch = item & 15; *(LAS u32x4*)(img + offb(r, ch)) = t[which][it]; } }
        if (ci < 7) { const int cn = dir ? 6 - ci : ci + 1; const int tokn = tok0 + cn * 128;
#pragma unroll
            for (int which = 1; which < 3; ++which) { const int cb = which == 1 ? kcol : vcolg;
#pragma unroll
                for (int it = 0; it < 4; ++it) { const int item = tl + 512 * it, r = item >> 4, ch = item & 15; t[which][it] = *(const u32x4*)(proj + (size_t)(tokn + r) * NPROJ + cb + 8 * ch); } } }
        if (is_m) { const float Atot = PS[2 * ci], bmax = PS[2 * ci + 1]; const float mprev = m_state, Ml = fmaxf(mprev, bmax);
            if (tid < 128) { const int j = tid; LAS float* pv = PV + ci * 384; const float A = pv[j], b = pv[128 + j], rb = pv[256 + j]; const float M = fmaxf(mprev, rb);
                vrow[j] = -M * LOG2E; vcol[j] = b * LOG2E; vwi[j] = __expf(mprev - M); vkw[j] = __expf(b - Ml); vemt[j] = __expf(-(A + M)); if (j == 0) vsc[0] = __expf(mprev - Ml); }
            m_state = Atot + Ml; aseg_sum += Atot;
        } else aseg_sum += 128.0f * lgam;
        __syncthreads();
        const float decay = vsc[0];
        if (!state_only) {
            int irow = 16 * w + fr; asm volatile("" : "+v"(irow));
            bf16x8 qf[4];
#pragma unroll
            for (int s = 0; s < 4; ++s) qf[s] = ROWFRAG(IMG_Q, 16 * w, s);
            f32x4 O[9];
            __builtin_amdgcn_s_setprio(1);
#pragma unroll
            for (int nt = 0; nt < 8; ++nt) { f32x4 a = (f32x4){0.f, 0.f, 0.f, 0.f}; LAUNDER_L16
                bf16x8 cf[4];
#pragma unroll
                for (int ks = 0; ks < 4; ++ks) cf[ks] = TRFRAG(IMG_C, nt, ks);
                __builtin_amdgcn_sched_barrier(0);
#pragma unroll
                for (int ks = 0; ks < 4; ++ks) a = MFMA16(cf[ks], qf[ks], a);
                O[nt] = a; }
            { f32x4 a = (f32x4){0.f, 0.f, 0.f, 0.f};
              if (is_m) {
#pragma unroll
                  for (int ks = 0; ks < 4; ++ks) a = MFMA16(TRFRAGX(IMG_CX, ks), qf[ks], a); }
              O[8] = a; }
            __builtin_amdgcn_s_setprio(0);
            const float wi = vwi[irow], rt = vrow[irow];
#pragma unroll
            for (int nt = 0; nt < 9; ++nt) O[nt] = O[nt] * wi;
#pragma unroll
            for (int nt = 0; nt < 8; ++nt) { f32x4 a = (f32x4){0.f, 0.f, 0.f, 0.f}; bf16x8 kr[4];
#pragma unroll
                for (int s = 0; s < 4; ++s) kr[s] = ROWFRAG(IMG_K, 16 * nt, s);
                __builtin_amdgcn_sched_barrier(0);
#pragma unroll
                for (int s = 0; s < 4; ++s) a = MFMA16(kr[s], qf[s], a);
                const f32x4 ct = *(const LAS f32x4*)(vcol + 16 * nt + 4 * fg); float p[4];
#pragma unroll
                for (int e = 0; e < 4; ++e) { const int j = 16 * nt + 4 * fg + e;
                    const bool keep = dir ? (is_m ? (j >= irow) : (j > irow)) : (j <= irow);
                    const float ex = __builtin_amdgcn_exp2f(rt + ct[e]); p[e] = keep ? a[e] * ex : 0.f; }
                u32x2 pv; pv.x = cvt_pk_bf16(p[0], p[1]); pv.y = cvt_pk_bf16(p[2], p[3]);
                { LAUNDER_X16 *(LAS u32x2*)(lds + IMG_Q + CWA(nt)) = pv; } __builtin_amdgcn_sched_barrier(0); }
            bf16x8 pf[4];
#pragma unroll
            for (int s = 0; s < 4; ++s) pf[s] = ROWFRAG(IMG_Q, 16 * w, s);
            bf16x8 kf[4], kraw[4];
#pragma unroll
            for (int ks = 0; ks < 4; ++ks) kraw[ks] = trfrag_(lds, IMG_K + 256u * (32u * ks) + ktb0, IMG_K + 256u * (32u * ks + 4u) + ktb1);
            __builtin_amdgcn_sched_barrier(0);
#pragma unroll
            for (int ks = 0; ks < 4; ++ks) { const bf16x8 raw = kraw[ks];
                const f32x4 k0 = *(const LAS f32x4*)(vkw + 32 * ks + 8 * fg), k1 = *(const LAS f32x4*)(vkw + 32 * ks + 8 * fg + 4);
                float f[8];
#pragma unroll
                for (int e = 0; e < 8; ++e) f[e] = __uint_as_float(((unsigned)(unsigned short)raw[e]) << 16) * (e < 4 ? k0[e] : k1[e - 4]);
                u32x4 pk; pk.x = cvt_pk_bf16(f[0], f[1]); pk.y = cvt_pk_bf16(f[2], f[3]); pk.z = cvt_pk_bf16(f[4], f[5]); pk.w = cvt_pk_bf16(f[6], f[7]);
                kf[ks] = __builtin_bit_cast(bf16x8, pk); }
            __builtin_amdgcn_s_setprio(1);
#pragma unroll
            for (int nt = 0; nt < 8; ++nt) { LAUNDER_L16
                bf16x8 vf[4];
#pragma unroll
                for (int ks = 0; ks < 4; ++ks) vf[ks] = TRFRAG(IMG_V, nt, ks);
                __builtin_amdgcn_sched_barrier(0);
                f32x4 a = Cacc[nt] * decay;
#pragma unroll
                for (int ks = 0; ks < 4; ++ks) { O[nt] = MFMA16(vf[ks], pf[ks], O[nt]); a = MFMA16(vf[ks], kf[ks], a); }
                Cacc[nt] = a; }
            if (is_m) { f32x4 a = Cacc[8] * decay;
#pragma unroll
                for (int ks = 0; ks < 4; ++ks) { const bf16x8 vx = TRFRAGX(IMG_VX, ks); O[8] = MFMA16(vx, pf[ks], O[8]); a = MFMA16(vx, kf[ks], a); }
                Cacc[8] = a; }
            __builtin_amdgcn_s_setprio(0);
            float hs = 1.0f;
            if (is_m) { const float den = __shfl(O[8][0], fr); hs = 1.0f / fmaxf(fabsf(den), vemt[irow]); }
            bf16_t* mrow = mixed + (size_t)(tok + irow) * DM + mcol + 4 * fg;
            if (!final_pass) {
#pragma unroll
                for (int nt = 0; nt < 8; ++nt) { u32x2 v; v.x = cvt_pk_bf16(O[nt][0] * hs, O[nt][1] * hs); v.y = cvt_pk_bf16(O[nt][2] * hs, O[nt][3] * hs); *(u32x2*)(mrow + 16 * nt) = v; }
            } else {
                float sum = 0.f;
#pragma unroll
                for (int nt = 0; nt < 8; ++nt) { const u32x2 hb = *(const u32x2*)(mrow + 16 * nt);
                    O[nt][0] = O[nt][0] * hs + bf_lo(hb.x); O[nt][1] = O[nt][1] * hs + bf_hi(hb.x); O[nt][2] = O[nt][2] * hs + bf_lo(hb.y); O[nt][3] = O[nt][3] * hs + bf_hi(hb.y);
                    sum += O[nt][0] + O[nt][1] + O[nt][2] + O[nt][3]; __builtin_amdgcn_sched_barrier(0); }
                sum += __shfl_xor(sum, 16); sum += __shfl_xor(sum, 32);
                const float mu = sum * (1.0f / 128.0f); float sq = 0.f;
#pragma unroll
                for (int nt = 0; nt < 8; ++nt)
#pragma unroll
                    for (int e = 0; e < 4; ++e) { const float d = O[nt][e] - mu; sq += d * d; }
                sq += __shfl_xor(sq, 16); sq += __shfl_xor(sq, 32);
                const float rs = rsqrtf(sq * (1.0f / 128.0f) + 1e-5f);
                const bf16_t* grow = proj + (size_t)(tok + irow) * NPROJ + gcol + 4 * fg;
#pragma unroll
                for (int nt = 0; nt < 8; ++nt) { const u32x2 gv = *(const u32x2*)(grow + 16 * nt); const f32x4 gw = *(const f32x4*)(gnw + 16 * nt + 4 * fg);
                    float gt[4] = {bf_lo(gv.x), bf_hi(gv.x), bf_lo(gv.y), bf_hi(gv.y)}; float y[4];
#pragma unroll
                    for (int e = 0; e < 4; ++e) { const float sg = sigmoidf_(gt[e]); const float gate = is_m ? sg : gt[e] * sg; y[e] = (O[nt][e] - mu) * rs * gw[e] * gate; }
                    u32x2 v; v.x = cvt_pk_bf16(y[0], y[1]); v.y = cvt_pk_bf16(y[2], y[3]); *(u32x2*)(mrow + 16 * nt) = v; __builtin_amdgcn_sched_barrier(0); }
            }
        }
        if (state_only) {
            bf16x8 kf[4], kraw[4];
#pragma unroll
            for (int ks = 0; ks < 4; ++ks) kraw[ks] = trfrag_(lds, IMG_K + 256u * (32u * ks) + ktb0, IMG_K + 256u * (32u * ks + 4u) + ktb1);
            __builtin_amdgcn_sched_barrier(0);
#pragma unroll
            for (int ks = 0; ks < 4; ++ks) { const bf16x8 raw = kraw[ks];
                const f32x4 k0 = *(const LAS f32x4*)(vkw + 32 * ks + 8 * fg), k1 = *(const LAS f32x4*)(vkw + 32 * ks + 8 * fg + 4);
                float f[8];
#pragma unroll
                for (int e = 0; e < 8; ++e) f[e] = __uint_as_float(((unsigned)(unsigned short)raw[e]) << 16) * (e < 4 ? k0[e] : k1[e - 4]);
                u32x4 pk; pk.x = cvt_pk_bf16(f[0], f[1]); pk.y = cvt_pk_bf16(f[2], f[3]); pk.z = cvt_pk_bf16(f[4], f[5]); pk.w = cvt_pk_bf16(f[6], f[7]);
                kf[ks] = __builtin_bit_cast(bf16x8, pk); }
#pragma unroll
            for (int nt = 0; nt < 8; ++nt) { f32x4 a = Cacc[nt] * decay; LAUNDER_L16
                bf16x8 vf[4];
#pragma unroll
                for (int ks = 0; ks < 4; ++ks) vf[ks] = TRFRAG(IMG_V, nt, ks);
                __builtin_amdgcn_sched_barrier(0);
#pragma unroll
                for (int ks = 0; ks < 4; ++ks) a = MFMA16(vf[ks], kf[ks], a);
                Cacc[nt] = a; }
            if (is_m) { f32x4 a = Cacc[8] * decay;
#pragma unroll
                for (int ks = 0; ks < 4; ++ks) a = MFMA16(TRFRAGX(IMG_VX, ks), kf[ks], a);
                Cacc[8] = a; }
        }
        if (!state_only) {
            __syncthreads();
#pragma unroll
            for (int nt = 0; nt < 8; ++nt) { u32x2 v; v.x = cvt_pk_bf16(Cacc[nt][0], Cacc[nt][1]); v.y = cvt_pk_bf16(Cacc[nt][2], Cacc[nt][3]);
                { LAUNDER_X16 *(LAS u32x2*)(lds + IMG_C + CWA(nt)) = v; } }
            { u32x2 v; v.x = cvt_pk_bf16(Cacc[8][0], Cacc[8][1]); v.y = cvt_pk_bf16(Cacc[8][2], Cacc[8][3]); *(LAS u32x2*)(lds + IMG_CX + 32 * (16 * w + fr) + 8 * fg) = v; }
        }
    }
}

__device__ __forceinline__ int tot_slot(int sg, int hd, int dir) {
    if (sg < 16) { const int seq = sg >> 3, s = sg & 7; return ((seq * 8 + hd) * 2 + dir) * 7 + (dir ? s - 1 : s); }
    const int seq = (sg - 16) >> 1; return 224 + (seq * 8 + hd) * 2 + dir;
}
__device__ __forceinline__ float head_lgam(const Params& P, int hd, int dir) { return hd < 4 ? logsigmoidf_(P.in[9][dir * 4 + hd]) : 0.f; }

__device__ void phase_mix1(const Params& P, LAS unsigned char* lds, const int G, const int bid) {
    unsigned char* dob = (unsigned char*)P.out; float* tot = (float*)(dob + DO_TOT); float* tots = (float*)(dob + DO_TOTS);
    for (int it = bid; it < NSLOT; it += G) {
        int sg, hd, dir;
        if (it < 224) { const int k = it % 7, r = it / 7; dir = r & 1; hd = (r >> 1) & 7; const int seq = r >> 4; sg = seq * 8 + (dir ? k + 1 : k); }
        else { const int r = it - 224; dir = r & 1; hd = (r >> 1) & 7; const int seq = r >> 4; sg = 16 + seq * 2 + (dir ? 1 : 0); }
        const int seqlen = sg < 16 ? 8192 : 2048; const int pos0 = (sg < 16 ? (sg & 7) : ((sg - 16) & 1)) * 1024;
        f32x4 C[9];
#pragma unroll
        for (int i = 0; i < 9; ++i) C[i] = (f32x4){0.f, 0.f, 0.f, 0.f};
        float m = 0.f, as = 0.f;
        mix_sweep(P, lds, sg * 1024, pos0, seqlen, hd, dir, true, false, C, m, as, head_lgam(P, hd, dir));
        float* tp = tot + ((size_t)it * 512 + threadIdx.x) * 36;
#pragma unroll
        for (int i = 0; i < 9; ++i) *(f32x4*)(tp + 4 * i) = C[i];
        if (threadIdx.x == 0) { tots[it * 2] = m; tots[it * 2 + 1] = as; }
    }
    { const int nfree = G - (NSLOT - G > 0 ? NSLOT - G : 0); const int first = G - nfree;
      __syncthreads();
      if (nfree > 0 && bid >= first) convert_rest(P, (LAS float*)lds, bid - first, nfree);
      else if (nfree <= 0) convert_rest(P, (LAS float*)lds, bid, G); }
}
__device__ void phase_mix2(const Params& P, LAS unsigned char* lds, const int G, const int bid) {
    unsigned char* dob = (unsigned char*)P.out; const float* tot = (const float*)(dob + DO_TOT); const float* tots = (const float*)(dob + DO_TOTS);
    for (int it = bid; it < 256; it += G) {
        const int sg = it >> 3, hd = it & 7;
        const int seqlen = sg < 16 ? 8192 : 2048; const int s = sg < 16 ? (sg & 7) : ((sg - 16) & 1), nseg = sg < 16 ? 8 : 2; const int sg0 = sg - s;
        for (int pass = 0; pass < 2; ++pass) { const int dir = pass ? 0 : 1;
            f32x4 C[9];
#pragma unroll
            for (int i = 0; i < 9; ++i) C[i] = (f32x4){0.f, 0.f, 0.f, 0.f};
            float m = 0.f, as = 0.f;
            const int nfold = dir ? nseg - 1 - s : s;
            for (int f = 0; f < nfold; ++f) { const int sp = dir ? nseg - 1 - f : f; const int slot = tot_slot(sg0 + sp, hd, dir);
                const float mseg = tots[slot * 2], aseg = tots[slot * 2 + 1];
                const float mnew = fmaxf(aseg + m, mseg), d0 = __expf(aseg + m - mnew), d1 = __expf(mseg - mnew);
                const float* tp = tot + ((size_t)slot * 512 + threadIdx.x) * 36;
#pragma unroll
                for (int i = 0; i < 9; ++i) C[i] = C[i] * d0 + *(const f32x4*)(tp + 4 * i) * d1;
                m = mnew; }
            mix_sweep(P, lds, sg * 1024, s * 1024, seqlen, hd, dir, false, pass == 1, C, m, as, head_lgam(P, hd, dir));
        }
    }
}

#define XB_TMO      128
#define XB_XCNT(j)  (256  + 64 * (j))
#define XB_XSUB(j)  (1280 + 64 * (j))
#define XB_XGEN(j)  (2304 + 64 * (j))
#define XB_TOP      3328
#define XB_TOPGEN   3392
#define XCD_BAR_WORDS 3456
#define XB_SPIN_CAP (1u << 18)

__device__ __forceinline__ unsigned xb_ld(unsigned* p)              { return __hip_atomic_load(p, __ATOMIC_RELAXED, __HIP_MEMORY_SCOPE_AGENT); }
__device__ __forceinline__ unsigned xb_add(unsigned* p, unsigned v) { return __hip_atomic_fetch_add(p, v, __ATOMIC_RELAXED, __HIP_MEMORY_SCOPE_AGENT); }
__device__ __forceinline__ unsigned xb_xcc_id() { return (unsigned)__builtin_amdgcn_s_getreg((3 << 11) | 20) & 0xFu; }
#define XB_SPIN(cond, bar) do { unsigned _sp = 0; while (cond) { __builtin_amdgcn_s_sleep(1); \
    if ((++_sp & 255u) == 0u) { if (xb_ld(&(bar)[XB_TMO])) break; if (_sp > XB_SPIN_CAP) { atomicAdd(&(bar)[XB_TMO], 1u); break; } } } } while (0)

struct XcdBarrier {
    unsigned* bar; unsigned x;
    volatile LAS unsigned* st;
};

__device__ __forceinline__ XcdBarrier xcd_barrier_post(unsigned* bar, volatile LAS unsigned* st) {
    XcdBarrier b; b.bar = bar; b.x = xb_xcc_id(); b.st = st;
    if (threadIdx.x == 0) (void)xb_add(&bar[XB_XCNT(b.x)], 1u);
    return b;
}
__device__ __forceinline__ void xcd_barrier_complete(unsigned* bar, unsigned x, unsigned& nloc, unsigned& nx) {
    const unsigned G = gridDim.x * gridDim.y * gridDim.z;
    unsigned sum, cnt, mine, sp = 0u;
    for (;;) {
        sum = 0u; cnt = 0u; mine = 0u;
#pragma unroll
        for (unsigned j = 0; j < 16; ++j) { const unsigned c = xb_ld(&bar[XB_XCNT(j)]); sum += c; cnt += (c > 0u) ? 1u : 0u; mine = (j == x) ? c : mine; }
        if (sum == G) break;
        __builtin_amdgcn_s_sleep(1);
        if ((++sp & 255u) == 0u) { if (xb_ld(&bar[XB_TMO])) break; if (sp > XB_SPIN_CAP) { atomicAdd(&bar[XB_TMO], 1u); break; } }
    }
    nloc = mine > 0u ? mine : 1u; nx = cnt > 0u ? cnt : 1u;
}

__device__ __forceinline__ void xcd_barrier(const XcdBarrier& b) {
    asm volatile("s_waitcnt vmcnt(0)" ::: "memory");
    __syncthreads();
    if (threadIdx.x == 0) {
        unsigned* bar = b.bar;
        __builtin_amdgcn_s_waitcnt(0);
        unsigned nloc = b.st[0], nx = b.st[1];
        if (nloc == 0u) { xcd_barrier_complete(bar, b.x, nloc, nx); b.st[0] = nloc; b.st[1] = nx; }
        const unsigned old = xb_add(&bar[XB_XSUB(b.x)], 1u);
        const unsigned gen = old / nloc;
        if (old + 1u == (gen + 1u) * nloc) {
            __builtin_amdgcn_fence(__ATOMIC_RELEASE, "agent");
            asm volatile("s_waitcnt vmcnt(0)" ::: "memory");
            const unsigned og = xb_add(&bar[XB_TOP], 1u);
            const unsigned tg = og / nx;
            if (og + 1u == (tg + 1u) * nx) xb_add(&bar[XB_TOPGEN], 1u);
            else XB_SPIN(xb_ld(&bar[XB_TOPGEN]) == tg, bar);
            __builtin_amdgcn_fence(__ATOMIC_ACQUIRE, "agent");
            xb_add(&bar[XB_XGEN(b.x)], 1u);
            asm volatile("s_waitcnt vmcnt(0)" ::: "memory");
        } else {
            XB_SPIN(xb_ld(&bar[XB_XGEN(b.x)]) == gen, bar);
            __builtin_amdgcn_fence(__ATOMIC_ACQUIRE, "agent");
            asm volatile("s_waitcnt vmcnt(0)" ::: "memory");
        }
    }
    __syncthreads();
}


__global__ void __launch_bounds__(512, 2) mega(Params P0) {
    extern __shared__ __attribute__((aligned(16))) unsigned char shm[];
    LAS unsigned char* lds = (LAS unsigned char*)shm;
    cg::grid_group grid = cg::this_grid();
    volatile LAS unsigned* xst = (volatile LAS unsigned*)(lds + 155632);
    if (threadIdx.x == 0) { xst[0] = 0u; xst[1] = 0u; }
    __syncthreads();
    XcdBarrier xb = xcd_barrier_post((unsigned*)((unsigned char*)P0.out + DO_BAR), xst);
    typedef const Params __attribute__((address_space(4))) * KArgP;
    const int ph_lo = P0.ph_lo, ph_hi = P0.ph_hi;
    for (int ph = ph_lo; ph <= ph_hi; ++ph) {
        int tid = threadIdx.x; asm volatile("" : "+v"(tid));
        int G = gridDim.x, bid = blockIdx.x; asm volatile("" : "+s"(G)); asm volatile("" : "+s"(bid));
        KArgP kp = (KArgP)__builtin_amdgcn_kernarg_segment_ptr(); asm volatile("" : "+s"(kp));
        Params P;
#pragma unroll
        for (int i = 0; i < 24; ++i) P.in[i] = kp->in[i];
        P.out = kp->out; P.ws = kp->ws; P.ph_lo = 0; P.ph_hi = 0;
        unsigned char* dob = (unsigned char*)P.out; unsigned char* ws = P.ws;
        if (ph == 0) phase0(P, lds, G, bid);
        else if (ph == 1) { pg8::Gemm g{(const bf16_t*)(dob + DO_ABF), (const bf16_t*)(dob + DO_W1T), NTOK, NPROJ, DM}; pg8::StaticOrder S; S.init(NTOK, NPROJ, G, bid);
            EpiProj E{(bf16_t*)(ws + WS_PROJ), (const f32x2*)(dob + DO_ROPE), (bf16_t*)(dob + DO_HQ), P.in[6], P.in[7]}; pg8::gemm_phase(lds, g, S, E); }
        else if (ph == 2) phase_conv(P, G, bid);
        else if (ph == 3) phase_mix1(P, lds, G, bid);
        else if (ph == 4) phase_mix2(P, lds, G, bid);
        else if (ph == 5) {
            { float* r2 = (float*)(ws + WS_RSS2); for (int i = bid * 512 + tid; i < 2 * NTOK; i += G * 512) r2[i] = 0.f;
              if (bid == 0 && tid == 0) __hip_atomic_store((unsigned*)(ws + WS_BAR), 0u, __ATOMIC_RELAXED, __HIP_MEMORY_SCOPE_AGENT); }
            pg8::Gemm g{(const bf16_t*)(dob + DO_MIXED), (const bf16_t*)(dob + DO_WOT), NTOK, DM, DM}; pg8::StaticOrder S; S.init(NTOK, DM, G, bid);
            EpiG2 E{P.in[0], P.in[1], (float*)(ws + WS_H1), (bf16_t*)(ws + WS_H1B), (float*)(dob + DO_RSS1)}; pg8::gemm_phase(lds, g, S, E); }
        else if (ph >= 6 && ph <= 9) { const int half = (ph - 6) >> 1, sub = (ph - 6) & 1;
            const bf16_t* hb = (const bf16_t*)(ws + WS_H1B) + (size_t)half * HALF_TOK * DM;
            if (sub == 0) { pg8::Gemm g{hb, (const bf16_t*)(dob + DO_WGT), HALF_TOK, 2 * DFF, DM}; pg8::StaticOrder S; S.init(HALF_TOK, 2 * DFF, G, bid);
                EpiF12 E{(bf16_t*)(dob + DO_G), (bf16_t*)(dob + DO_GR), (bf16_t*)(dob + DO_UP), (const float*)(dob + DO_RSS1), P.in[16], P.in[17], half}; pg8::gemm_phase(lds, g, S, E);
                if (half == 1) {
                    const int nun = (HALF_TOK / 256) * (2 * DFF / 256), rem = nun % G; const int nfree = rem ? G - rem : 0, sub = rem ? bid - rem : -1;
                    if (sub >= 0) { asm volatile("s_waitcnt vmcnt(0)" ::: "memory"); __syncthreads();
                        pg8::Gemm g2{(const bf16_t*)(ws + WS_PBF), (const bf16_t*)(ws + WS_WPP), NTOK, DM, PLE}; pg8::StaticOrder S2; S2.init(NTOK, DM, nfree, sub); S2.hi = 256;
                        EpiPP E2{(bf16_t*)(ws + WS_PPT), (bf16_t*)dob}; pg8::gemm_phase(lds, g2, S2, E2); } }
                if (half == 0) {
                    const int nun = (HALF_TOK / 256) * (2 * DFF / 256), rem = nun % G; const int nfree = rem ? G - rem : G, sub = rem ? bid - rem : bid;
                    if (sub >= 0) { bf16_t* pbf = (bf16_t*)(ws + WS_PBF); int tid = threadIdx.x; asm volatile("" : "+v"(tid));
                        for (int i = sub * 512 + tid; i < NTOK * PLE / 4; i += nfree * 512) { const int row = i >> 6, c4 = i & 63; const f32x4 v = *(const f32x4*)(prow(P, row) + 4 * c4);
                            u32x2 w; w.x = cvt_pk_bf16(v[0], v[1]); w.y = cvt_pk_bf16(v[2], v[3]); *(u32x2*)(pbf + (size_t)row * PLE + 4 * c4) = w; }
                        LAS float* tile = (LAS float*)lds;
                        for (int t = sub; t < 128 + 32; t += nfree) {
                            if (t < 128) { const int kt = t & 15, ntl = t >> 4; wt_tile(P.in[21], DM, kt * 64, ntl * 128, (bf16_t*)(ws + WS_WPG), DM, P.in[20], 1.0f, tile); }
                            else { const int u2 = t - 128, kt = u2 & 3, ntl = u2 >> 2; wt_tile(P.in[19], DM, kt * 64, ntl * 128, (bf16_t*)(ws + WS_WPP), PLE, nullptr, 1.0f, tile); } } } } }
            else { pg8::Gemm g{(const bf16_t*)(dob + DO_G), (const bf16_t*)(dob + DO_WDT), HALF_TOK, DM, DFF}; pg8::StaticOrder S; S.init(HALF_TOK, DM, G, bid);
                { pg8::Unit uu; int lastpm = -1; for (int i = 0; S.next(i, uu); ++i) if (uu.pm != lastpm) { ffn_fix((bf16_t*)(dob + DO_G), (const bf16_t*)(dob + DO_GR), (const bf16_t*)(dob + DO_UP), P.in[16], P.in[17], uu.pm, half); lastpm = uu.pm; } }
                EpiF3 E{(float*)(ws + WS_H1), (bf16_t*)(ws + WS_H1B), (float*)(ws + WS_RSS2), half}; pg8::gemm_phase(lds, g, S, E); } }
        else if (ph == 10) {
            const bool pre = (((HALF_TOK / 256) * (2 * DFF / 256)) % G) != 0;
            bf16_t* T0 = pre ? (bf16_t*)(ws + WS_PPT) : (bf16_t*)dob; bf16_t* T1 = pre ? (bf16_t*)dob : (bf16_t*)(dob + 32 * MiB);
            { pg8::Gemm g{(const bf16_t*)(ws + WS_PBF), (const bf16_t*)(ws + WS_WPP), NTOK, DM, PLE}; pg8::StaticOrder S; S.init(NTOK, DM, G, bid); if (pre) S.lo = 256;
              EpiPP E{T0, T1}; pg8::gemm_phase(lds, g, S, E); }
            asm volatile("s_waitcnt vmcnt(0)" ::: "memory"); __syncthreads();
            { pg8::Gemm g{(const bf16_t*)(ws + WS_H1B), (const bf16_t*)(ws + WS_WPG), NTOK, DM, DM}; pg8::StaticOrder S; S.init(NTOK, DM, G, bid);
              EpiPG E{T0, T1, (float*)(ws + WS_H1), (const float*)(ws + WS_RSS2), P.in[22], (float*)(ws + WS_RSS3)}; pg8::gemm_phase(lds, g, S, E); } }
        else if (ph == 11) { const float* r3 = (const float*)(ws + WS_RSS3); const float* fw = P.in[23]; const f32x4* h3 = (const f32x4*)(ws + WS_H1);
            const int nchunk = NTOK * DM / 4 / 1024; const int wv = bid * 8 + (tid >> 6), lane = tid & 63;
            for (int ck = wv; ck < nchunk; ck += G * 8) { f32x4 v[16];
#pragma unroll
                for (int j = 0; j < 16; ++j) v[j] = __builtin_nontemporal_load(h3 + (ck * 16 + j) * 64 + lane);
#pragma unroll
                for (int j = 0; j < 16; ++j) { const int i = (ck * 16 + j) * 64 + lane; const int row = i >> 8, c4 = i & 255; const float rstd = rsqrtf(r3[row] * (1.0f / DM) + 1e-6f);
                    __builtin_nontemporal_store(v[j] * rstd * *(const f32x4*)(fw + 4 * c4), (f32x4*)P.out + i); } } }
        if (ph < ph_hi) {
            if (ph_lo < 0) grid.sync();
            xcd_barrier(xb);
        }
    }
}

extern "C" void kernel_launch(void* const* d_in, const int* in_sizes, int n_in, void* d_out, int out_size, void* d_ws, size_t ws_size, hipStream_t stream) {
    static int grid_blocks = 0;
    if (!grid_blocks) {
        int dev = 0, cus = 0, per_cu = 0;
        hipGetDevice(&dev);
        hipDeviceGetAttribute(&cus, hipDeviceAttributeMultiprocessorCount, dev);
        if (hipFuncSetAttribute((const void*)mega, hipFuncAttributeMaxDynamicSharedMemorySize, LDS_BYTES) != hipSuccess) { fprintf(stderr, "hipFuncSetAttribute failed\n"); }
        hipOccupancyMaxActiveBlocksPerMultiprocessor(&per_cu, (const void*)mega, 512, LDS_BYTES);
        if (per_cu < 1) per_cu = 1;
        grid_blocks = cus * 1;
        (void)hipGetLastError();
    }
    if (n_in < 24 || ws_size < 248 * MiB) { fprintf(stderr, "kernel_launch: unexpected inputs / workspace\n"); return; }
    Params p{};
    for (int i = 0; i < 24; ++i) p.in[i] = (const float*)d_in[i];
    p.out = (float*)d_out; p.ws = (unsigned char*)d_ws; p.ph_lo = 0; p.ph_hi = 11;
    if (hipMemsetAsync((char*)d_out + DO_BAR, 0, XCD_BAR_WORDS * 4, stream) != hipSuccess) { fprintf(stderr, "memset failed\n"); return; }
    void* args[] = {&p};
    hipError_t e = hipLaunchCooperativeKernel((const void*)mega, dim3(grid_blocks), dim3(512), args, LDS_BYTES, stream);
    if (e != hipSuccess) fprintf(stderr, "cooperative launch failed: %s (grid %d)\n", hipGetErrorString(e), grid_blocks);
}
```

```cpp
#include <hip/hip_runtime.h>
#include <hip/hip_cooperative_groups.h>
#include <cstdio>
namespace cg = cooperative_groups;

#define LAS __attribute__((address_space(3)))
typedef unsigned short bf16_t;
typedef short bf16x8 __attribute__((ext_vector_type(8)));
typedef short s16x4 __attribute__((ext_vector_type(4)));
typedef float f32x4 __attribute__((ext_vector_type(4)));
typedef float f32x2 __attribute__((ext_vector_type(2)));
typedef unsigned u32x4 __attribute__((ext_vector_type(4)));
typedef unsigned u32x2 __attribute__((ext_vector_type(2)));

constexpr int NTOK = 32768, DM = 1024, NPROJ = 4096, INCOLS = 4112, DFF = 2816, PLE = 256, HALF_TOK = 16384;
constexpr size_t MiB = 1024ull * 1024ull;
constexpr size_t WS_PROJ = 0, WS_H1 = 0, WS_H1B = 128 * MiB, WS_PBF = 192 * MiB, WS_WPG = 208 * MiB, WS_WPP = 210 * MiB,
                 WS_RSS2 = 211 * MiB, WS_RSS3 = 211 * MiB + 128 * 1024, WS_GH = 212 * MiB, WS_BAR = 214 * MiB, WS_PPT = 216 * MiB;
constexpr size_t DO_ABF = 0, DO_MIXED = 0, DO_GATES = 64 * MiB, DO_ROPE = 66 * MiB, DO_TOT = 70 * MiB, DO_TOTS = 95 * MiB,
                 DO_RSS1 = 99 * MiB + 256 * 1024, DO_W1T = 100 * MiB, DO_WOT = 108 * MiB, DO_WGT = 110 * MiB, DO_WUT = 110 * MiB + 5632 * 1024,
                 DO_WDT = 121 * MiB, DO_G = 0, DO_GR = 88 * MiB, DO_UP = 93 * MiB + 512 * 1024, DO_HQ = 95 * MiB + 64 * 1024, DO_BAR = 99 * MiB + 512 * 1024;
constexpr int LDS_BYTES = 155648;
constexpr int NSLOT = 352;

struct Params { const float* in[24]; float* out; unsigned char* ws; int ph_lo, ph_hi; };

#define NTL(p) __builtin_nontemporal_load((const f32x4*)(p))
#define NTS(v, p) __builtin_nontemporal_store((v), (f32x4*)(p))
__device__ __forceinline__ unsigned cvt_pk_bf16(float lo, float hi) { unsigned r; asm volatile("v_cvt_pk_bf16_f32 %0, %1, %2" : "=v"(r) : "v"(lo), "v"(hi)); return r; }
__device__ __forceinline__ float bf_lo(unsigned w) { return __uint_as_float(w << 16); }
__device__ __forceinline__ float bf_hi(unsigned w) { return __uint_as_float(w & 0xffff0000u); }
__device__ __forceinline__ float sigmoidf_(float x) { return 1.0f / (1.0f + __expf(-x)); }
__device__ __forceinline__ float logsigmoidf_(float x) { return fminf(x, 0.0f) - log1pf(__expf(-fabsf(x))); }
__device__ __forceinline__ f32x2 gelu_pk(f32x2 v) {
    const f32x2 av = __builtin_elementwise_abs(v), d = av * 0.2316418882f + 1.0f;
    f32x2 t; t.x = __builtin_amdgcn_rcpf(d.x); t.y = __builtin_amdgcn_rcpf(d.y);
    f32x2 q = t * 0.5307027145f + (-0.7265760135f); q = q * t + 0.7107068705f; q = q * t + (-0.142248368f); q = q * t + 0.127414796f; q = q * t;
    const f32x2 s = (v * v) * (-0.72134752044f);
    f32x2 e; e.x = __builtin_amdgcn_exp2f(s.x); e.y = __builtin_amdgcn_exp2f(s.y);
    const f32x2 m = v * (q * e), r = v - m;
    f32x2 o; o.x = v.x < 0.f ? m.x : r.x; o.y = v.y < 0.f ? m.y : r.y; return o;
}
__device__ __forceinline__ const float* xrow(const Params& P, int t) { return t < HALF_TOK ? P.in[0] + (size_t)t * DM : P.in[1] + (size_t)(t - HALF_TOK) * DM; }
__device__ __forceinline__ const float* prow(const Params& P, int t) { return t < HALF_TOK ? P.in[2] + (size_t)t * PLE : P.in[3] + (size_t)(t - HALF_TOK) * PLE; }

namespace pg8 {
constexpr int BM = 256, BK = 64, HALF = 128, HTB = HALF * BK * 2, STAGE_BYTES = 8 * HTB, NXCD = 8, WGM = 8;
__device__ __forceinline__ int lds_byte(int r, int c) { const int st = (r >> 4) * 2 + (c >> 5), rr = r & 15, cc = c & 31, ob = rr * 64 + cc * 2; return st * 1024 + (ob ^ (((ob >> 9) & 1) << 5)); }
__device__ __forceinline__ void stage_rc(int b, int& R, int& C) { const int st = b / 1024, sb = b % 1024, swz = sb ^ (((sb >> 9) & 1) << 5); R = (st >> 1) * 16 + swz / 64; C = (st & 1) * 32 + (swz % 64) / 2; }
__device__ __forceinline__ int perm32(int rho) { const int n = rho >> 4, i = rho & 15; return 8 * (i >> 2) + 4 * n + (i & 3); }
struct Unit { int pm, pn, L; };
struct Gemm { const bf16_t* A; const bf16_t* Bt; int M, N, K; };
struct StaticOrder {
    int nM, nN, nwg, G, c, lo, hi;
    __device__ void init(int M, int N, int G_, int c_) { nM = M / BM; nN = N / BM; nwg = nM * nN; G = G_; c = c_; lo = 0; hi = nwg; }
    __device__ bool next(int i, Unit& u) const {
        const long L = (long)lo + (long)i * G + c; if (L >= hi) return false; u.L = (int)L;
        int wgid = (int)L; { const int q = nwg / NXCD, r = nwg % NXCD, xcd = wgid % NXCD, off = wgid / NXCD; wgid = (xcd < r ? xcd * (q + 1) : r * (q + 1) + (xcd - r) * q) + off; }
        const int nig = WGM * nN, gid = wgid / nig, fm = gid * WGM, gsz = (nM - fm) < WGM ? (nM - fm) : WGM;
        u.pm = fm + ((wgid % nig) % gsz); u.pn = (wgid % nig) / gsz; return true;
    }
};
template <class Epi>
__device__ __forceinline__ void gemm_phase(LAS unsigned char* lds, const Gemm g, const StaticOrder& S, const Epi& E) {
    int tid = threadIdx.x; asm volatile("" : "+v"(tid));
    const int wid = __builtin_amdgcn_readfirstlane(tid >> 6), lane = tid & 63, wr = wid >> 2, wc = wid & 3, fr = lane & 15, fq = lane >> 4;
    int K = g.K; asm volatile("" : "+s"(K));
    const int nt = K / BK;
    unsigned voffA[2], voffB[2];
#pragma unroll
    for (int i = 0; i < 2; ++i) { int R, C; stage_rc(tid * 16 + i * 8192, R, C); const int Rb = (R & ~31) + perm32(R & 31);
        voffA[i] = (unsigned)(R * K + C) * 2u; voffB[i] = (unsigned)(Rb * K + C) * 2u; }
    const size_t kstep = (size_t)(BK * 2);
    const size_t hstep = (size_t)HALF * K * 2;
    const size_t tstep = 2 * hstep;
    const unsigned ldsw = (unsigned)wid * 1024u;
    const int aoff = lds_byte(wr * 64 + fr, fq * 8), boff = lds_byte(wc * 32 + fr, fq * 8);
#define PG8_SA(b, h) (((b) * 2 + (h)) * HTB)
#define PG8_SB(b, h) ((4 + (b) * 2 + (h)) * HTB)
#define PG8_STAGE(bufoff, gbase, voff) do { _Pragma("unroll") for (int _i = 0; _i < 2; ++_i) \
        __builtin_amdgcn_global_load_lds((const unsigned*)((const char*)(gbase) + (voff)[_i]), (LAS unsigned*)(lds + (bufoff) + ldsw + _i * 8192), 16, 0, 0); } while (0)
#define PG8_LDA(dst, b, h) do { _Pragma("unroll") for (int m = 0; m < 4; ++m) _Pragma("unroll") for (int k = 0; k < 2; ++k) dst[m][k] = *(const LAS bf16x8*)(lds + PG8_SA(b, h) + aoff + m * 2048 + k * 1024); } while (0)
#define PG8_LDB(dst, b, h) do { _Pragma("unroll") for (int n = 0; n < 2; ++n) _Pragma("unroll") for (int k = 0; k < 2; ++k) dst[n][k] = *(const LAS bf16x8*)(lds + PG8_SB(b, h) + boff + n * 2048 + k * 1024); } while (0)
#define PG8_MMA(ai, bj, At, Bt) do { __builtin_amdgcn_s_setprio(1); _Pragma("unroll") for (int m = 0; m < 4; ++m) _Pragma("unroll") for (int n = 0; n < 2; ++n) _Pragma("unroll") for (int k = 0; k < 2; ++k) \
        acc[ai][bj][m][n] = __builtin_amdgcn_mfma_f32_16x16x32_bf16(Bt[n][k], At[m][k], acc[ai][bj][m][n], 0, 0, 0); __builtin_amdgcn_s_setprio(0); } while (0)
#define PG8_WAIT_V(n) asm volatile("s_waitcnt vmcnt(" #n ")" ::: "memory")
#define PG8_WAIT_L(n) asm volatile("s_waitcnt lgkmcnt(" #n ")" ::: "memory")
#define PG8_BAR __builtin_amdgcn_s_barrier()
#define PG8_SCHED __builtin_amdgcn_sched_barrier(0)
    Unit cur, nxt; int ui = 0;
    if (!S.next(0, cur)) return;
    f32x4 acc[2][2][4][2];
#pragma unroll
    for (int a = 0; a < 2; ++a)
#pragma unroll
        for (int b = 0; b < 2; ++b)
#pragma unroll
            for (int m = 0; m < 4; ++m)
#pragma unroll
                for (int n = 0; n < 2; ++n) acc[a][b][m][n] = (f32x4){0.f, 0.f, 0.f, 0.f};
    bf16x8 At[4][2], B0[2][2], B1[2][2];
    const char* cA = (const char*)g.A + (size_t)cur.pm * tstep; const char* cB = (const char*)g.Bt + (size_t)cur.pn * tstep;
    PG8_STAGE(PG8_SB(0, 0), cB, voffB); PG8_STAGE(PG8_SA(0, 0), cA, voffA); PG8_STAGE(PG8_SB(0, 1), cB + hstep, voffB); PG8_STAGE(PG8_SA(0, 1), cA + hstep, voffA);
    if (wr == 1) PG8_BAR;
    PG8_WAIT_V(4); PG8_BAR;
    PG8_STAGE(PG8_SB(1, 0), cB + kstep, voffB); PG8_STAGE(PG8_SA(1, 0), cA + kstep, voffA); PG8_STAGE(PG8_SB(1, 1), cB + hstep + kstep, voffB);
    PG8_WAIT_V(6); PG8_BAR;
    for (;;) {
        const bool has_next = S.next(ui + 1, nxt);
        const char* nA = has_next ? (const char*)g.A + (size_t)nxt.pm * tstep : cA; const char* nB = has_next ? (const char*)g.Bt + (size_t)nxt.pn * tstep : cB;
        for (int t = 0; t < nt; t += 2) {
            const bool last = (t == nt - 2);
            const char* a1 = cA + (size_t)(t + 1) * kstep;
            const char* a2 = last ? nA : cA + (size_t)(t + 2) * kstep; const char* b2 = last ? nB : cB + (size_t)(t + 2) * kstep;
            const char* a3 = a2 + kstep; const char* b3 = b2 + kstep;
            PG8_LDB(B0, 0, 0); PG8_SCHED; PG8_LDA(At, 0, 0); PG8_STAGE(PG8_SA(1, 1), a1 + hstep, voffA);
            PG8_WAIT_L(8); PG8_BAR; PG8_WAIT_L(0); PG8_MMA(0, 0, At, B0); PG8_BAR; PG8_SCHED;
            PG8_LDB(B1, 0, 1); PG8_STAGE(PG8_SB(0, 0), b2, voffB);
            PG8_BAR; PG8_WAIT_L(0); PG8_MMA(0, 1, At, B1); PG8_BAR;
            PG8_LDA(At, 0, 1); PG8_STAGE(PG8_SA(0, 0), a2, voffA);
            PG8_BAR; PG8_WAIT_L(0); PG8_MMA(1, 0, At, B0); PG8_BAR; PG8_SCHED;
            PG8_STAGE(PG8_SB(0, 1), b2 + hstep, voffB);
            PG8_WAIT_V(6); PG8_BAR; PG8_MMA(1, 1, At, B1); PG8_BAR;
            PG8_LDB(B0, 1, 0); PG8_SCHED; PG8_LDA(At, 1, 0); PG8_STAGE(PG8_SA(0, 1), a2 + hstep, voffA);
            PG8_WAIT_L(8); PG8_BAR; PG8_WAIT_L(0); PG8_MMA(0, 0, At, B0); PG8_BAR; PG8_SCHED;
            PG8_LDB(B1, 1, 1); PG8_STAGE(PG8_SB(1, 0), b3, voffB);
            PG8_BAR; PG8_WAIT_L(0); PG8_MMA(0, 1, At, B1); PG8_BAR;
            PG8_LDA(At, 1, 1); PG8_STAGE(PG8_SA(1, 0), a3, voffA);
            PG8_BAR; PG8_WAIT_L(0); PG8_MMA(1, 0, At, B0); PG8_BAR; PG8_SCHED;
            PG8_STAGE(PG8_SB(1, 1), b3 + hstep, voffB);
            PG8_WAIT_V(6); PG8_BAR; PG8_MMA(1, 1, At, B1); PG8_BAR;
        }
        E(acc, cur, wr, wc, fr, fq);
        if (!has_next) break;
#pragma unroll
        for (int a = 0; a < 2; ++a)
#pragma unroll
            for (int b = 0; b < 2; ++b)
#pragma unroll
                for (int m = 0; m < 4; ++m)
#pragma unroll
                    for (int n = 0; n < 2; ++n) acc[a][b][m][n] = (f32x4){0.f, 0.f, 0.f, 0.f};
        cur = nxt; cA = nA; cB = nB; ++ui;
    }
    PG8_WAIT_V(0);
    if (wr == 0) PG8_BAR;
    PG8_BAR;
#undef PG8_SA
#undef PG8_SB
#undef PG8_STAGE
#undef PG8_LDA
#undef PG8_LDB
#undef PG8_MMA
#undef PG8_WAIT_V
#undef PG8_WAIT_L
#undef PG8_BAR
#undef PG8_SCHED
}
}
using pg8::Unit;
typedef f32x4 AccT[2][2][4][2];

__device__ __forceinline__ unsigned dpp_prev(unsigned cur, unsigned below) {
    const int t = __builtin_amdgcn_update_dpp(0, (int)below, 0x121  , 0xf, 0xf, false);
    return (unsigned)__builtin_amdgcn_update_dpp(t, (int)cur, 0x111  , 0xf, 0xf, false);
}
__device__ __forceinline__ unsigned dpp_next(unsigned cur, unsigned above) {
    const int t = __builtin_amdgcn_update_dpp(0, (int)above, 0x12F  , 0xf, 0xf, false);
    return (unsigned)__builtin_amdgcn_update_dpp(t, (int)cur, 0x101  , 0xf, 0xf, false);
}
__device__ __forceinline__ float dppf_prev(float cur, float below) { return __uint_as_float(dpp_prev(__float_as_uint(cur), __float_as_uint(below))); }
__device__ __forceinline__ float dppf_next(float cur, float above) { return __uint_as_float(dpp_next(__float_as_uint(cur), __float_as_uint(above))); }
struct EpiProj {
    bf16_t* O; const f32x2* rope; bf16_t* HQ; const float* cw; const float* cb;
    __device__ __forceinline__ void operator()(AccT& acc, const Unit& u, int wr, int wc, int fr, int fq) const {
        asm volatile("" : "+v"(fr)); asm volatile("" : "+v"(fq));
        const int row0 = u.pm * 256 + wr * 64 + fr, col0 = u.pn * 256 + wc * 32 + 8 * fq;
        const bool rot = u.pn < 4, mqk = (u.pn >= 8 && u.pn < 12);
        const int i0 = 16 * wc + 4 * fq;
        if (mqk) {
            const int mc0 = col0 - 2048;
#pragma unroll
            for (int ai = 0; ai < 2; ++ai) { const int grp = u.pm * 4 + ai * 2 + wr;
#pragma unroll
                for (int bj = 0; bj < 2; ++bj) { const int mc = mc0 + bj * 128; const float mul = mc < 512 ? 0.08838834764831845f : 1.0f;
#pragma unroll
                    for (int n = 0; n < 2; ++n) {
                        const f32x4 w0 = *(const f32x4*)(cw + mc + 4 * n), w1 = *(const f32x4*)(cw + 1024 + mc + 4 * n), w2 = *(const f32x4*)(cw + 2048 + mc + 4 * n), b = *(const f32x4*)(cb + mc + 4 * n);
#pragma unroll
                        for (int m = 0; m < 4; ++m) { const int lr = m * 16 + fr; const f32x4 gc = acc[ai][bj][m][n]; f32x4 o;
#pragma unroll
                            for (int j = 0; j < 4; ++j) { const float gp = dppf_prev(gc[j], m > 0 ? acc[ai][bj][m - 1][n][j] : 0.f), gn = dppf_next(gc[j], m < 3 ? acc[ai][bj][m + 1][n][j] : 0.f);
                                const float uu = gp * w0[j] + gc[j] * w1[j] + gn * w2[j] + b[j]; o[j] = uu * sigmoidf_(uu) * mul; }
                            u32x2 w; w.x = cvt_pk_bf16(o[0], o[1]); w.y = cvt_pk_bf16(o[2], o[3]);
                            *(u32x2*)(O + (size_t)(grp * 64 + lr) * NPROJ + col0 + bj * 128 + 4 * n) = w;
                            if (m == 0 || m == 3) { if (lr < 2 || lr > 61) { u32x2 wg; wg.x = cvt_pk_bf16(gc[0], gc[1]); wg.y = cvt_pk_bf16(gc[2], gc[3]);
                                *(u32x2*)(HQ + (size_t)(grp * 4 + (lr < 2 ? lr : lr - 60)) * 1024 + mc + 4 * n) = wg; } } } } } }
            return; }
#pragma unroll
        for (int ai = 0; ai < 2; ++ai)
#pragma unroll
            for (int m = 0; m < 4; ++m) { const int row = row0 + ai * 128 + m * 16; bf16_t* rowp = O + (size_t)row * NPROJ + col0;
                f32x4 cs0 = (f32x4){1.f, 0.f, 1.f, 0.f}, cs1 = cs0;
                if (rot) { const int pos = row < HALF_TOK ? (row & 8191) : ((row - HALF_TOK) & 2047); const f32x2* rp = rope + (size_t)pos * 64 + i0; cs0 = *(const f32x4*)rp; cs1 = *(const f32x4*)(rp + 2); }
#pragma unroll
                for (int bj = 0; bj < 2; ++bj) { f32x4 v0 = acc[ai][bj][m][0], v1 = acc[ai][bj][m][1];
                    if (rot) { const f32x4 a = v0, b = v1;
                        v0[0] = a[0] * cs0[0] - a[1] * cs0[1]; v0[1] = a[1] * cs0[0] + a[0] * cs0[1]; v0[2] = a[2] * cs0[2] - a[3] * cs0[3]; v0[3] = a[3] * cs0[2] + a[2] * cs0[3];
                        v1[0] = b[0] * cs1[0] - b[1] * cs1[1]; v1[1] = b[1] * cs1[0] + b[0] * cs1[1]; v1[2] = b[2] * cs1[2] - b[3] * cs1[3]; v1[3] = b[3] * cs1[2] + b[2] * cs1[3]; }
                    u32x4 w; w.x = cvt_pk_bf16(v0[0], v0[1]); w.y = cvt_pk_bf16(v0[2], v0[3]); w.z = cvt_pk_bf16(v1[0], v1[1]); w.w = cvt_pk_bf16(v1[2], v1[3]);
                    *(u32x4*)(rowp + bj * 128) = w; }
                __builtin_amdgcn_sched_barrier(0); }
    }
};
struct EpiG2 {
    const float* x0; const float* x1; float* H; bf16_t* HB; float* rss;
    __device__ __forceinline__ void operator()(AccT& acc, const Unit& u, int wr, int wc, int fr, int fq) const {
        asm volatile("" : "+v"(fr)); asm volatile("" : "+v"(fq));
        const int row0 = u.pm * 256 + wr * 64 + fr, col0 = u.pn * 256 + wc * 32 + 8 * fq;
        f32x4 xv[2][4];
        { const int row = row0; const float* xr = (row < HALF_TOK ? x0 + (size_t)row * DM : x1 + (size_t)(row - HALF_TOK) * DM) + col0;
          xv[0][0] = NTL(xr); xv[0][1] = NTL(xr + 4); xv[0][2] = NTL(xr + 128); xv[0][3] = NTL(xr + 132); }
#pragma unroll
        for (int r = 0; r < 8; ++r) { const int ai = r >> 2, m = r & 3; const int row = row0 + ai * 128 + m * 16;
            if (r < 7) { const int rn = row0 + ((r + 1) >> 2) * 128 + ((r + 1) & 3) * 16; const float* xr = (rn < HALF_TOK ? x0 + (size_t)rn * DM : x1 + (size_t)(rn - HALF_TOK) * DM) + col0;
                xv[(r + 1) & 1][0] = NTL(xr); xv[(r + 1) & 1][1] = NTL(xr + 4); xv[(r + 1) & 1][2] = NTL(xr + 128); xv[(r + 1) & 1][3] = NTL(xr + 132); }
            float* hr = H + (size_t)row * DM + col0; float ss = 0.f;
#pragma unroll
            for (int bj = 0; bj < 2; ++bj) {
                f32x4 v0 = acc[ai][bj][m][0] + xv[r & 1][2 * bj], v1 = acc[ai][bj][m][1] + xv[r & 1][2 * bj + 1];
                NTS(v0, hr + bj * 128); NTS(v1, hr + bj * 128 + 4);
                u32x4 w; w.x = cvt_pk_bf16(v0[0], v0[1]); w.y = cvt_pk_bf16(v0[2], v0[3]); w.z = cvt_pk_bf16(v1[0], v1[1]); w.w = cvt_pk_bf16(v1[2], v1[3]);
                *(u32x4*)(HB + (size_t)row * DM + col0 + bj * 128) = w;
#pragma unroll
                for (int j = 0; j < 4; ++j) ss += v0[j] * v0[j] + v1[j] * v1[j]; }
            ss += __shfl_xor(ss, 16); ss += __shfl_xor(ss, 32);
            if (fq == 0) unsafeAtomicAdd(rss + row, ss); __builtin_amdgcn_sched_barrier(0); }
    }
};
struct EpiF12 {
    bf16_t* ACT; bf16_t* GR; bf16_t* UP; const float* rss; const float* cw; const float* cb; int half;
    __device__ __forceinline__ void operator()(AccT& acc, const Unit& u, int wr, int wc, int fr, int fq) const {
        asm volatile("" : "+v"(fr)); asm volatile("" : "+v"(fq));
        const int fcol = u.pn * 128 + wc * 32 + 8 * fq;
#pragma unroll
        for (int ai = 0; ai < 2; ++ai) { const int gidx = u.pm * 4 + ai * 2 + wr;
#pragma unroll
            for (int m = 0; m < 4; ++m) { const float rstd = rsqrtf(rss[half * HALF_TOK + gidx * 64 + m * 16 + fr] * (1.0f / DM) + 1e-6f);
#pragma unroll
                for (int n = 0; n < 2; ++n) { acc[ai][0][m][n] = acc[ai][0][m][n] * rstd; acc[ai][1][m][n] = acc[ai][1][m][n] * rstd; } }
#pragma unroll
            for (int n = 0; n < 2; ++n) {
                const f32x4 w0 = *(const f32x4*)(cw + fcol + 4 * n), w1 = *(const f32x4*)(cw + DFF + fcol + 4 * n), w2 = *(const f32x4*)(cw + 2 * DFF + fcol + 4 * n), b = *(const f32x4*)(cb + fcol + 4 * n);
#pragma unroll
                for (int m = 0; m < 4; ++m) { const int lr = m * 16 + fr;
                    const f32x4 gc = acc[ai][0][m][n], up = acc[ai][1][m][n]; f32x4 uu;
#pragma unroll
                    for (int j = 0; j < 4; ++j) { const float gp = dppf_prev(gc[j], m > 0 ? acc[ai][0][m - 1][n][j] : 0.f), gn = dppf_next(gc[j], m < 3 ? acc[ai][0][m + 1][n][j] : 0.f);
                        uu[j] = gp * w0[j] + gc[j] * w1[j] + gn * w2[j] + b[j]; }
                    const f32x2 ga = gelu_pk((f32x2){uu[0], uu[1]}), gb = gelu_pk((f32x2){uu[2], uu[3]});
                    u32x2 wa; wa.x = cvt_pk_bf16(ga.x * up[0], ga.y * up[1]); wa.y = cvt_pk_bf16(gb.x * up[2], gb.y * up[3]);
                    *(u32x2*)(ACT + (size_t)(gidx * 64 + lr) * DFF + fcol + 4 * n) = wa;
                    if (m == 0 || m == 3) {
                        if (lr == 0 || lr == 63) { u32x2 wu; wu.x = cvt_pk_bf16(up[0], up[1]); wu.y = cvt_pk_bf16(up[2], up[3]); *(u32x2*)(UP + (size_t)(gidx * 2 + (lr == 63 ? 1 : 0)) * DFF + fcol + 4 * n) = wu; }
                        if (lr < 2 || lr > 61) { u32x2 wg; wg.x = cvt_pk_bf16(gc[0], gc[1]); wg.y = cvt_pk_bf16(gc[2], gc[3]); *(u32x2*)(GR + (size_t)(gidx * 4 + (lr < 2 ? lr : lr - 60)) * DFF + fcol + 4 * n) = wg; } } } }
        }
    }
};
__device__ void ffn_fix(bf16_t* ACT, const bf16_t* GR, const bf16_t* UP, const float* cw, const float* cb, int pm, int half) {
    int tid = threadIdx.x; asm volatile("" : "+v"(tid));
    const int seqgroups = half ? 32 : 128;
    for (int it = tid; it < 8 * 352; it += 512) { const int br = it / 352, col = (it % 352) * 8; const int group = pm * 4 + (br >> 1), which = br & 1;
        const bool seq_first = (group % seqgroups) == 0, seq_last = (group % seqgroups) == seqgroups - 1;
        const bf16_t* pp = which ? GR + (size_t)(group * 4 + 2) * DFF : GR + (size_t)((seq_first ? group : group - 1) * 4 + 3) * DFF;
        const bf16_t* pc = GR + (size_t)(group * 4 + (which ? 3 : 0)) * DFF;
        const bf16_t* pn = which ? GR + (size_t)((seq_last ? group : group + 1) * 4 + 0) * DFF : GR + (size_t)(group * 4 + 1) * DFF;
        const float mp = (!which && seq_first) ? 0.f : 1.f, mn = (which && seq_last) ? 0.f : 1.f;
        const u32x4 gp = *(const u32x4*)(pp + col), gc = *(const u32x4*)(pc + col), gn = *(const u32x4*)(pn + col), up = *(const u32x4*)(UP + (size_t)(group * 2 + which) * DFF + col);
        u32x4 ov;
#pragma unroll
        for (int q = 0; q < 4; ++q) { const int c = col + 2 * q;
            const float u0 = bf_lo(gp[q]) * mp * cw[c] + bf_lo(gc[q]) * cw[DFF + c] + bf_lo(gn[q]) * mn * cw[2 * DFF + c] + cb[c];
            const float u1 = bf_hi(gp[q]) * mp * cw[c + 1] + bf_hi(gc[q]) * cw[DFF + c + 1] + bf_hi(gn[q]) * mn * cw[2 * DFF + c + 1] + cb[c + 1];
            const f32x2 ge = gelu_pk((f32x2){u0, u1}); ov[q] = cvt_pk_bf16(ge.x * bf_lo(up[q]), ge.y * bf_hi(up[q])); }
        *(u32x4*)(ACT + (size_t)(group * 64 + (which ? 63 : 0)) * DFF + col) = ov; }
    asm volatile("s_waitcnt vmcnt(0)" ::: "memory"); __syncthreads();
}
struct EpiF3 {
    float* H; bf16_t* HB; float* rss; int half;
    __device__ __forceinline__ void operator()(AccT& acc, const Unit& u, int wr, int wc, int fr, int fq) const {
        asm volatile("" : "+v"(fr)); asm volatile("" : "+v"(fq));
        const int row0 = half * HALF_TOK + u.pm * 256 + wr * 64 + fr, col0 = u.pn * 256 + wc * 32 + 8 * fq;
        f32x4 hv[2][4];
        { const float* hr = H + (size_t)row0 * DM + col0; hv[0][0] = NTL(hr); hv[0][1] = NTL(hr + 4); hv[0][2] = NTL(hr + 128); hv[0][3] = NTL(hr + 132); }
#pragma unroll
        for (int r = 0; r < 8; ++r) { const int ai = r >> 2, m = r & 3; const int row = row0 + ai * 128 + m * 16;
            if (r < 7) { const int rn = row0 + ((r + 1) >> 2) * 128 + ((r + 1) & 3) * 16; const float* hn = H + (size_t)rn * DM + col0;
                hv[(r + 1) & 1][0] = NTL(hn); hv[(r + 1) & 1][1] = NTL(hn + 4); hv[(r + 1) & 1][2] = NTL(hn + 128); hv[(r + 1) & 1][3] = NTL(hn + 132); }
            float* hr = H + (size_t)row * DM + col0; float ss = 0.f;
#pragma unroll
            for (int bj = 0; bj < 2; ++bj) {
                f32x4 v0 = acc[ai][bj][m][0] + hv[r & 1][2 * bj], v1 = acc[ai][bj][m][1] + hv[r & 1][2 * bj + 1];
                NTS(v0, hr + bj * 128); NTS(v1, hr + bj * 128 + 4);
                u32x4 w; w.x = cvt_pk_bf16(v0[0], v0[1]); w.y = cvt_pk_bf16(v0[2], v0[3]); w.z = cvt_pk_bf16(v1[0], v1[1]); w.w = cvt_pk_bf16(v1[2], v1[3]);
                *(u32x4*)(HB + (size_t)row * DM + col0 + bj * 128) = w;
#pragma unroll
                for (int j = 0; j < 4; ++j) ss += v0[j] * v0[j] + v1[j] * v1[j]; }
            ss += __shfl_xor(ss, 16); ss += __shfl_xor(ss, 32);
            if (fq == 0) unsafeAtomicAdd(rss + row, ss); __builtin_amdgcn_sched_barrier(0); }
    }
};
struct EpiPP {
    bf16_t* T0; bf16_t* T1;
    __device__ __forceinline__ void operator()(AccT& acc, const Unit& u, int wr, int wc, int fr, int fq) const {
        asm volatile("" : "+v"(fr)); asm volatile("" : "+v"(fq));
        bf16_t* base = (u.L < 256 ? T0 : T1) + (size_t)(u.L & 255) * 65536 + (wr * 64 + fr) * 256 + wc * 32 + 8 * fq;
#pragma unroll
        for (int ai = 0; ai < 2; ++ai)
#pragma unroll
            for (int m = 0; m < 4; ++m) { bf16_t* rowp = base + (ai * 128 + m * 16) * 256;
#pragma unroll
                for (int bj = 0; bj < 2; ++bj) { const f32x4 v0 = acc[ai][bj][m][0], v1 = acc[ai][bj][m][1];
                    u32x4 w; w.x = cvt_pk_bf16(v0[0], v0[1]); w.y = cvt_pk_bf16(v0[2], v0[3]); w.z = cvt_pk_bf16(v1[0], v1[1]); w.w = cvt_pk_bf16(v1[2], v1[3]);
                    *(u32x4*)(rowp + bj * 128) = w; } }
    }
};
struct EpiPG {
    const bf16_t* T0; const bf16_t* T1; float* H; const float* rss2; const float* bias; float* rss3;
    __device__ __forceinline__ void operator()(AccT& acc, const Unit& u, int wr, int wc, int fr, int fq) const {
        asm volatile("" : "+v"(fr)); asm volatile("" : "+v"(fq));
        const int row0 = u.pm * 256 + wr * 64 + fr, col0 = u.pn * 256 + wc * 32 + 8 * fq;
        f32x4 hv[2][4]; u32x4 pv[2][2]; float rs[2];
        const bf16_t* ppbase = (u.L < 256 ? T0 : T1) + (size_t)(u.L & 255) * 65536 + (wr * 64 + fr) * 256 + wc * 32 + 8 * fq;
        { const float* hr = H + (size_t)row0 * DM + col0; const bf16_t* pp = ppbase;
          hv[0][0] = NTL(hr); hv[0][1] = NTL(hr + 4); hv[0][2] = NTL(hr + 128); hv[0][3] = NTL(hr + 132);
          pv[0][0] = *(const u32x4*)pp; pv[0][1] = *(const u32x4*)(pp + 128); rs[0] = rss2[row0]; }
#pragma unroll
        for (int r = 0; r < 8; ++r) { const int ai = r >> 2, m = r & 3; const int row = row0 + ai * 128 + m * 16;
            if (r < 7) { const int rn = row0 + ((r + 1) >> 2) * 128 + ((r + 1) & 3) * 16; const float* hn = H + (size_t)rn * DM + col0; const bf16_t* pn = ppbase + (((r + 1) >> 2) * 128 + ((r + 1) & 3) * 16) * 256;
                hv[(r + 1) & 1][0] = NTL(hn); hv[(r + 1) & 1][1] = NTL(hn + 4); hv[(r + 1) & 1][2] = NTL(hn + 128); hv[(r + 1) & 1][3] = NTL(hn + 132);
                pv[(r + 1) & 1][0] = *(const u32x4*)pn; pv[(r + 1) & 1][1] = *(const u32x4*)(pn + 128); rs[(r + 1) & 1] = rss2[rn]; }
            float* hp = H + (size_t)row * DM + col0; float ss = 0.f; const float rstd = rsqrtf(rs[r & 1] * (1.0f / DM) + 1e-6f);
#pragma unroll
            for (int bj = 0; bj < 2; ++bj) { const u32x4 pw = pv[r & 1][bj];
                const f32x4 b0 = *(const f32x4*)(bias + col0 + bj * 128), b1 = *(const f32x4*)(bias + col0 + bj * 128 + 4);
                const f32x4 p0 = (f32x4){bf_lo(pw.x), bf_hi(pw.x), bf_lo(pw.y), bf_hi(pw.y)}, p1 = (f32x4){bf_lo(pw.z), bf_hi(pw.z), bf_lo(pw.w), bf_hi(pw.w)};
                f32x4 g0 = acc[ai][bj][m][0] * rstd + b0, g1 = acc[ai][bj][m][1] * rstd + b1;
#pragma unroll
                for (int j = 0; j < 4; ++j) { g0[j] = sigmoidf_(g0[j]); g1[j] = sigmoidf_(g1[j]); }
                const f32x4 v0 = hv[r & 1][2 * bj] + p0 * g0, v1 = hv[r & 1][2 * bj + 1] + p1 * g1;
                NTS(v0, hp + bj * 128); NTS(v1, hp + bj * 128 + 4);
#pragma unroll
                for (int j = 0; j < 4; ++j) ss += v0[j] * v0[j] + v1[j] * v1[j]; }
            ss += __shfl_xor(ss, 16); ss += __shfl_xor(ss, 32);
            if (fq == 0) unsafeAtomicAdd(rss3 + row, ss); __builtin_amdgcn_sched_barrier(0); }
    }
};

__device__ void wt_tile(const float* src, int ld, int k0, int n0, bf16_t* dst, int Kdst, const float* kscale, float mul, LAS float* tile, bool rotperm = false, int drow0 = -1) {
    int tid = threadIdx.x; asm volatile("" : "+v"(tid));
    float v[16];
#pragma unroll
    for (int i = 0; i < 16; ++i) { const int k = (tid >> 7) + 4 * i, n = tid & 127; v[i] = src[(size_t)(k0 + k) * ld + n0 + n]; }
#pragma unroll
    for (int i = 0; i < 16; ++i) { const int k = (tid >> 7) + 4 * i, n = tid & 127; float x = v[i] * mul; if (kscale) x *= kscale[k0 + k]; tile[k * 129 + n] = x; }
    __syncthreads();
#pragma unroll
    for (int i = 0; i < 8; ++i) { const int n = (tid >> 5) + 16 * i, k2 = (tid & 31) * 2;
        const float a = tile[k2 * 129 + n], b = tile[(k2 + 1) * 129 + n]; int nn = (drow0 >= 0 ? drow0 : n0) + n; if (rotperm) nn = (nn & ~127) | (2 * (nn & 63) + ((nn >> 6) & 1));
        *(unsigned*)(dst + (size_t)nn * Kdst + k0 + k2) = cvt_pk_bf16(a, b); }
    __syncthreads();
}
__device__ void convert_rest(const Params& P, LAS float* tile, int sub, int nsub) {
    unsigned char* dob = (unsigned char*)P.out;
    const int T2 = 16 * 8, T3 = 16 * 22, T4 = 16 * 22, T5 = 44 * 8, TT = T2 + T3 + T4 + T5;
    for (int t = sub; t < TT; t += nsub) {
        if (t < T2) { const int kt = t & 15, ntl = t >> 4; wt_tile(P.in[12], DM, kt * 64, ntl * 128, (bf16_t*)(dob + DO_WOT), DM, nullptr, 1.0f, tile); }
        else if (t < T2 + T3) { const int u = t - T2, kt = u & 15, ntl = u >> 4; wt_tile(P.in[14], DFF, kt * 64, ntl * 128, (bf16_t*)(dob + DO_WGT), DM, P.in[13], 1.0f, tile, false, ntl * 256); }
        else if (t < T2 + T3 + T4) { const int u = t - T2 - T3, kt = u & 15, ntl = u >> 4; wt_tile(P.in[15], DFF, kt * 64, ntl * 128, (bf16_t*)(dob + DO_WGT), DM, P.in[13], 1.0f, tile, false, ntl * 256 + 128); }
        else { const int u = t - T2 - T3 - T4, kt = u % 44, ntl = u / 44; wt_tile(P.in[18], DM, kt * 64, ntl * 128, (bf16_t*)(dob + DO_WDT), DFF, nullptr, 1.0f, tile); }
    }
}

__device__ void phase0(const Params& P, LAS unsigned char* lds, const int G, const int bid) {
    int tid = threadIdx.x; asm volatile("" : "+v"(tid));
    const int wid = tid >> 6, lane = tid & 63;
    unsigned char* dob = (unsigned char*)P.out;
    { float* r1 = (float*)(dob + DO_RSS1); for (int i = bid * 512 + tid; i < NTOK; i += G * 512) r1[i] = 0.f; }
    { f32x2* rope = (f32x2*)(dob + DO_ROPE);
      for (int i = bid * 512 + tid; i < 8192 * 64; i += G * 512) { const int pos = i >> 6, f = i & 63;
          const float inv = powf(10000.0f, -(float)(2 * f) / 128.0f); const float ang = (float)pos * inv; float s, c; sincosf(ang, &s, &c); rope[i] = (f32x2){c, s}; } }
    { LAS float* tile = (LAS float*)lds;
      for (int t = bid; t < 512; t += G) { const int kt = t & 15, ntl = t >> 4; wt_tile(P.in[5], INCOLS, kt * 64, ntl * 128, (bf16_t*)(dob + DO_W1T), DM, nullptr, ntl < 4 ? 0.08838834764831845f : 1.0f, tile, ntl < 8); } }
    LAS float* wg = (LAS float*)(lds + 40960);
    { const float* win = P.in[5];
#pragma unroll
      for (int i = 0; i < 8; ++i) { const int k = (tid >> 2) + 128 * i, q = tid & 3; const f32x4 v = *(const f32x4*)(win + (size_t)k * INCOLS + NPROJ + 4 * q);
          const int slot = (k & 3) * 256 + (k >> 8) * 64 + ((k >> 2) & 63); *(LAS f32x4*)(wg + slot * 20 + 4 * q) = v; }
      __syncthreads(); }
    { bf16_t* abf = (bf16_t*)(dob + DO_ABF); float* gates = (float*)(dob + DO_GATES);
      const float* nw = P.in[4]; const float* gb = P.in[8];
      f32x4 w4[4];
#pragma unroll
      for (int i = 0; i < 4; ++i) w4[i] = *(const f32x4*)(nw + 4 * lane + 256 * i);
      const int gcol = ((lane >> 5) & 1) * 8 + ((lane >> 4) & 1) * 4 + ((lane >> 3) & 1) * 2 + ((lane >> 2) & 1);
      const float gbias = gb[gcol];
      for (int row0 = bid * 8 + wid; row0 < NTOK; row0 += G * 8 * 4) {
          f32x4 vv[4][4];
#pragma unroll
          for (int rr = 0; rr < 4; ++rr) { const int row = row0 + rr * G * 8; const float* xr = xrow(P, row < NTOK ? row : row0);
#pragma unroll
              for (int i = 0; i < 4; ++i) vv[rr][i] = __builtin_nontemporal_load((const f32x4*)(xr + 4 * lane + 256 * i)); }
#pragma unroll
          for (int rr = 0; rr < 4; ++rr) { const int row = row0 + rr * G * 8; if (row >= NTOK) continue;
              f32x4 (&v)[4] = vv[rr]; float ss = 0.f;
#pragma unroll
              for (int i = 0; i < 4; ++i)
#pragma unroll
                  for (int j = 0; j < 4; ++j) ss += v[i][j] * v[i][j];
#pragma unroll
              for (int o = 32; o >= 1; o >>= 1) ss += __shfl_xor(ss, o);
              const float rstd = rsqrtf(ss * (1.0f / DM) + 1e-6f);
              float ga[16];
#pragma unroll
              for (int c = 0; c < 16; ++c) ga[c] = 0.f;
#pragma unroll
              for (int i = 0; i < 4; ++i) { v[i] = v[i] * rstd * w4[i];
                  u32x2 w; w.x = cvt_pk_bf16(v[i][0], v[i][1]); w.y = cvt_pk_bf16(v[i][2], v[i][3]);
                  *(u32x2*)(abf + (size_t)row * DM + 4 * lane + 256 * i) = w;
#pragma unroll
                  for (int j = 0; j < 4; ++j) { const LAS float* wr_ = wg + (j * 256 + i * 64 + lane) * 20; const float a = v[i][j];
#pragma unroll
                      for (int q = 0; q < 4; ++q) { const f32x4 wv = *(const LAS f32x4*)(wr_ + 4 * q);
                          ga[4 * q] += a * wv[0]; ga[4 * q + 1] += a * wv[1]; ga[4 * q + 2] += a * wv[2]; ga[4 * q + 3] += a * wv[3]; } } }
              float r8[8], r4[4], r2[2], r1;
#pragma unroll
              for (int c = 0; c < 8; ++c) { const bool hi = (lane & 32) != 0; const float send = hi ? ga[c] : ga[c + 8], keep = hi ? ga[c + 8] : ga[c]; r8[c] = keep + __shfl_xor(send, 32); }
#pragma unroll
              for (int c = 0; c < 4; ++c) { const bool hi = (lane & 16) != 0; const float send = hi ? r8[c] : r8[c + 4], keep = hi ? r8[c + 4] : r8[c]; r4[c] = keep + __shfl_xor(send, 16); }
#pragma unroll
              for (int c = 0; c < 2; ++c) { const bool hi = (lane & 8) != 0; const float send = hi ? r4[c] : r4[c + 2], keep = hi ? r4[c + 2] : r4[c]; r2[c] = keep + __shfl_xor(send, 8); }
              { const bool hi = (lane & 4) != 0; const float send = hi ? r2[0] : r2[1], keep = hi ? r2[1] : r2[0]; r1 = keep + __shfl_xor(send, 4); }
              r1 += __shfl_xor(r1, 2); r1 += __shfl_xor(r1, 1);
              if ((lane & 3) == 0) { float gv = r1 + gbias; if (gcol >= 8) gv = logsigmoidf_(gv); gates[(size_t)row * 16 + gcol] = gv; }
          }
      } }
}

__device__ void phase_conv(const Params& P, const int G, const int bid) {
    int tid = threadIdx.x; asm volatile("" : "+v"(tid));
    unsigned char* dob = (unsigned char*)P.out;
    bf16_t* proj = (bf16_t*)(P.ws + WS_PROJ); const bf16_t* HQ = (const bf16_t*)(dob + DO_HQ);
    const float* cw = P.in[6]; const float* cbv = P.in[7];
    for (int it = bid * 512 + tid; it < 512 * 2 * 128; it += G * 512) { const int ch = it & 127, which = (it >> 7) & 1, g = it >> 8; const int col = ch * 8;
        const int gs = g < 256 ? (g & 127) : ((g - 256) & 31), ng = g < 256 ? 128 : 32; const bool seq_first = gs == 0, seq_last = gs == ng - 1;
        const bf16_t* pp = which ? HQ + (size_t)(g * 4 + 2) * 1024 : HQ + (size_t)((seq_first ? g : g - 1) * 4 + 3) * 1024;
        const bf16_t* pc = HQ + (size_t)(g * 4 + (which ? 3 : 0)) * 1024;
        const bf16_t* pn = which ? HQ + (size_t)((seq_last ? g : g + 1) * 4 + 0) * 1024 : HQ + (size_t)(g * 4 + 1) * 1024;
        const float mp = (!which && seq_first) ? 0.f : 1.f, mn = (which && seq_last) ? 0.f : 1.f, mul = col < 512 ? 0.08838834764831845f : 1.0f;
        const u32x4 gp = *(const u32x4*)(pp + col), gc = *(const u32x4*)(pc + col), gn = *(const u32x4*)(pn + col); u32x4 ov;
#pragma unroll
        for (int q = 0; q < 4; ++q) { const int c = col + 2 * q;
            const float u0 = bf_lo(gp[q]) * mp * cw[c] + bf_lo(gc[q]) * cw[1024 + c] + bf_lo(gn[q]) * mn * cw[2048 + c] + cbv[c];
            const float u1 = bf_hi(gp[q]) * mp * cw[c + 1] + bf_hi(gc[q]) * cw[1024 + c + 1] + bf_hi(gn[q]) * mn * cw[2048 + c + 1] + cbv[c + 1];
            ov[q] = cvt_pk_bf16(u0 * sigmoidf_(u0) * mul, u1 * sigmoidf_(u1) * mul); }
        *(u32x4*)(proj + (size_t)(g * 64 + (which ? 63 : 0)) * NPROJ + 2048 + col) = ov; }
}

constexpr unsigned IMG_Q = 0, IMG_K = 32768, IMG_V = 65536, IMG_C = 98304, IMG_VX = 131072, IMG_CX = 135168, VEC0 = 139264;
__device__ __forceinline__ unsigned offb(unsigned row, unsigned ch) { return 256u * row + 16u * (ch ^ (((row & 3u) << 2) | ((row >> 2) & 3u))); }
struct FragB { unsigned rb[4], lp, L16, txb, rp, X16; };
__device__ __forceinline__ void fragb_init(FragB& F, int w, int fr, int fg) {
    const unsigned q = fr >> 2, p = fr & 3, swr = ((fr & 3u) << 2) | ((fr >> 2) & 3u);
#pragma unroll
    for (int s = 0; s < 4; ++s) { unsigned v = 256u * fr + 16u * ((4u * s + fg) ^ swr); asm volatile("" : "+v"(v)); F.rb[s] = v; }
    const unsigned L = (q << 2) | ((fg & 1u) << 1) | (p >> 1);
    F.lp = 256u * (8u * fg + q) + 8u * (p & 1u); F.L16 = 16u * L;
    F.txb = 32u * (8u * fg + q) + 8u * p;
    F.rp = 256u * (16u * w + fr) + 8u * (fg & 1u); F.X16 = 16u * ((fg >> 1) ^ swr);
    asm volatile("" : "+v"(F.lp)); asm volatile("" : "+v"(F.L16)); asm volatile("" : "+v"(F.txb)); asm volatile("" : "+v"(F.rp)); asm volatile("" : "+v"(F.X16));
}
#define ROWFRAG(img, rowbase, s) (*(const LAS bf16x8*)(lds + (img) + 256u * (rowbase) + FB.rb[s]))
__device__ __forceinline__ bf16x8 trfrag_(LAS unsigned char* lds, unsigned a0, unsigned a1) {
    const s16x4 lo = __builtin_amdgcn_ds_read_tr16_b64_v4i16((LAS s16x4*)(lds + a0));
    const s16x4 hi = __builtin_amdgcn_ds_read_tr16_b64_v4i16((LAS s16x4*)(lds + a1));
    return (bf16x8){lo[0], lo[1], lo[2], lo[3], hi[0], hi[1], hi[2], hi[3]};
}
#define TRA(c, t) (FB.lp + (l16 ^ (16u * (2u * (c) + (t)))))
#define TRFRAG(img, c, ks) trfrag_(lds, (img) + 256u * (32u * (ks)) + TRA(c, 0), (img) + 256u * (32u * (ks) + 4u) + TRA(c, 1))
#define TRFRAGX(img, ks) trfrag_(lds, (img) + 32u * (32u * (ks)) + FB.txb, (img) + 32u * (32u * (ks) + 4u) + FB.txb)
#define CWA(nt) (FB.rp + (x16 ^ (32u * (nt))))
#define LAUNDER_L16 unsigned l16 = FB.L16; asm volatile("" : "+v"(l16));
#define LAUNDER_X16 unsigned x16 = FB.X16; asm volatile("" : "+v"(x16));
#define MFMA16(a, b, c) __builtin_amdgcn_mfma_f32_16x16x32_bf16((a), (b), (c), 0, 0, 0)

__device__ void mix_sweep(const Params& P, LAS unsigned char* lds, int tok0, int pos0, int seqlen, int hd, int dir, bool state_only, bool final_pass,
                          f32x4 (&Cacc)[9], float& m_state, float& aseg_sum, float lgam) {
    int tid = threadIdx.x; asm volatile("" : "+v"(tid));
    const int w = __builtin_amdgcn_readfirstlane(tid >> 6), lane = tid & 63, fr = lane & 15, fg = lane >> 4;
    const bool is_m = hd >= 4; const int h = hd & 3;
    unsigned char* dob = (unsigned char*)P.out;
    const bf16_t* proj = (const bf16_t*)(P.ws + WS_PROJ); const float* gates = (const float*)(dob + DO_GATES);
    const f32x2* rope = (const f32x2*)(dob + DO_ROPE); bf16_t* mixed = (bf16_t*)(dob + DO_MIXED);
    LAS float* vrow = (LAS float*)(lds + VEC0); LAS float* vcol = vrow + 128; LAS float* vwi = vrow + 256; LAS float* vkw = vrow + 384; LAS float* vemt = vrow + 512; LAS float* vsc = vrow + 640;
    const int qcol = is_m ? 2048 + h * 128 : h * 128, kcol = is_m ? 2560 + h * 128 : 512 + h * 128, vcolg = is_m ? 3072 + h * 128 : 1024 + h * 128;
    const int gcol = is_m ? 3584 + h * 128 : 1536 + h * 128, mcol = is_m ? 512 + h * 128 : h * 128;
    const float* gnw = (is_m ? P.in[11] : P.in[10]) + h * 128;
    const float LOG2E = 1.4426950408889634f;
    FragB FB; fragb_init(FB, w, fr, fg);
    unsigned ktb0, ktb1; { const unsigned q = fr >> 2, p = fr & 3, L = (q << 2) | ((fg & 1u) << 1) | (p >> 1); ktb0 = 256u * (8u * fg + q) + 8u * (p & 1u) + 16u * (L ^ (2u * w)); ktb1 = 256u * (8u * fg + q) + 8u * (p & 1u) + 16u * (L ^ (2u * w + 1u)); asm volatile("" : "+v"(ktb0)); asm volatile("" : "+v"(ktb1)); }
    __syncthreads();
    if (!state_only) {
#pragma unroll
        for (int nt = 0; nt < 8; ++nt) { u32x2 v; v.x = cvt_pk_bf16(Cacc[nt][0], Cacc[nt][1]); v.y = cvt_pk_bf16(Cacc[nt][2], Cacc[nt][3]);
            { LAUNDER_X16 *(LAS u32x2*)(lds + IMG_C + CWA(nt)) = v; } }
        { u32x2 v; v.x = cvt_pk_bf16(Cacc[8][0], Cacc[8][1]); v.y = cvt_pk_bf16(Cacc[8][2], Cacc[8][3]); *(LAS u32x2*)(lds + IMG_CX + 32 * (16 * w + fr) + 8 * fg) = v; }
    }
    if (tid < 128) { unsigned zz = 0u; asm volatile("" : "+v"(zz)); u32x4 v0 = (u32x4){is_m ? 0x3F80u : zz, zz, zz, zz}; u32x4 z = (u32x4){zz, zz, zz, zz}; *(LAS u32x4*)(lds + IMG_VX + 32 * tid) = v0; *(LAS u32x4*)(lds + IMG_VX + 32 * tid + 16) = z; }
    LAS float* PV = (LAS float*)(lds + 141888); LAS float* PS = PV + 8 * 3 * 128;
    if (is_m) { const int c = dir ? 7 - w : w; const int tokc = tok0 + c * 128;
        const int u0 = 2 * lane, u1 = 2 * lane + 1; const int j0 = dir ? 127 - u0 : u0, j1 = dir ? 127 - u1 : u1;
        const float x0 = gates[(size_t)(tokc + j0) * 16 + 8 + dir * 4 + h], x1 = gates[(size_t)(tokc + j1) * 16 + 8 + dir * 4 + h];
        const float i0 = gates[(size_t)(tokc + j0) * 16 + dir * 4 + h], i1 = gates[(size_t)(tokc + j1) * 16 + dir * 4 + h];
        const float ps = x0 + x1; float sc = ps;
#pragma unroll
        for (int o = 1; o < 64; o <<= 1) { const float t = __shfl_up(sc, o); if (lane >= o) sc += t; }
        const float excl = sc - ps, A0 = excl + x0, A1 = excl + ps, Atot = __shfl(sc, 63);
        const float b0 = i0 - A0, b1 = i1 - A1; const float pm = fmaxf(b0, b1); float scm = pm;
#pragma unroll
        for (int o = 1; o < 64; o <<= 1) { const float t = __shfl_up(scm, o); if (lane >= o) scm = fmaxf(scm, t); }
        float exm = __shfl_up(scm, 1); if (lane == 0) exm = -3.0e38f;
        const float rb0 = fmaxf(exm, b0), rb1 = fmaxf(rb0, b1), bmax = __shfl(scm, 63);
        LAS float* pv = PV + w * 384;
        pv[j0] = A0; pv[j1] = A1; pv[128 + j0] = b0; pv[128 + j1] = b1; pv[256 + j0] = rb0; pv[256 + j1] = rb1;
        if (lane == 0) { PS[2 * w] = Atot; PS[2 * w + 1] = bmax; }
    } else if (tid < 128) { const int j = tid, u = dir ? 127 - j : j; const float A = (float)(u + 1) * lgam, Atot = 128.0f * lgam;
        vrow[j] = A * LOG2E; vcol[j] = -A * LOG2E; vwi[j] = __expf(A); vkw[j] = __expf(Atot - A); vemt[j] = 1.f; if (j == 0) vsc[0] = __expf(Atot); }
    u32x4 t[3][4];
    { const int c = dir ? 7 : 0; const int tok = tok0 + c * 128;
#pragma unroll
      for (int which = 1; which < 3; ++which) { const int cb = which == 0 ? qcol : (which == 1 ? kcol : vcolg);
#pragma unroll
          for (int it = 0; it < 4; ++it) { const int item = tid + 512 * it, r = item >> 4, ch = item & 15; t[which][it] = *(const u32x4*)(proj + (size_t)(tok + r) * NPROJ + cb + 8 * ch); } } }
    for (int ci = 0; ci < 8; ++ci) {
        const int c = dir ? 7 - ci : ci; const int tok = tok0 + c * 128;
        __syncthreads();
        int tl = tid; asm volatile("" : "+v"(tl));
        if (!state_only) {
#pragma unroll
            for (int it = 0; it < 4; ++it) { const int item = tl + 512 * it, r = item >> 4, ch = item & 15; t[0][it] = *(const u32x4*)(proj + (size_t)(tok + r) * NPROJ + qcol + 8 * ch); } }
#pragma unroll
        for (int which = 2; which >= 0; --which) { if (which == 0 && state_only) continue; LAS unsigned char* img = lds + (which == 0 ? IMG_Q : (which == 1 ? IMG_K : IMG_V));
#pragma unroll
            for (int it = 0; it < 4; ++it) { const int item = tl + 512 * it, r = item >> 4, ch = item & 15; *(LAS u32x4*)(img + offb(r, ch)) = t[which][it]; } }
        if (ci < 7) { const int cn = dir ? 6 - ci : ci + 1; const int tokn = tok0 + cn * 128;
#pragma unroll
            for (int which = 1; which < 3; ++which) { const int cb = which == 1 ? kcol : vcolg;
#pragma unroll
                for (int it = 0; it < 4; ++it) { const int item = tl + 512 * it, r = item >> 4, ch = item & 15; t[which][it] = *(const u32x4*)(proj + (size_t)(tokn + r) * NPROJ + cb + 8 * ch); } } }
        if (is_m) { const float Atot = PS[2 * ci], bmax = PS[2 * ci + 1]; const float mprev = m_state, Ml = fmaxf(mprev, bmax);
            if (tid < 128) { const int j = tid; LAS float* pv = PV + ci * 384; const float A = pv[j], b = pv[128 + j], rb = pv[256 + j]; const float M = fmaxf(mprev, rb);
                vrow[j] = -M * LOG2E; vcol[j] = b * LOG2E; vwi[j] = __expf(mprev - M); vkw[j] = __expf(b - Ml); vemt[j] = __expf(-(A + M)); if (j == 0) vsc[0] = __expf(mprev - Ml); }
            m_state = Atot + Ml; aseg_sum += Atot;
        } else aseg_sum += 128.0f * lgam;
        __syncthreads();
        const float decay = vsc[0];
        if (!state_only) {
            int irow = 16 * w + fr; asm volatile("" : "+v"(irow));
            bf16x8 qf[4];
#pragma unroll
            for (int s = 0; s < 4; ++s) qf[s] = ROWFRAG(IMG_Q, 16 * w, s);
            f32x4 O[9];
            __builtin_amdgcn_s_setprio(1);
#pragma unroll
            for (int nt = 0; nt < 8; ++nt) { f32x4 a = (f32x4){0.f, 0.f, 0.f, 0.f}; LAUNDER_L16
                bf16x8 cf[4];
#pragma unroll
                for (int ks = 0; ks < 4; ++ks) cf[ks] = TRFRAG(IMG_C, nt, ks);
                __builtin_amdgcn_sched_barrier(0);
#pragma unroll
                for (int ks = 0; ks < 4; ++ks) a = MFMA16(cf[ks], qf[ks], a);
                O[nt] = a; }
            { f32x4 a = (f32x4){0.f, 0.f, 0.f, 0.f};
              if (is_m) {
#pragma unroll
                  for (int ks = 0; ks < 4; ++ks) a = MFMA16(TRFRAGX(IMG_CX, ks), qf[ks], a); }
              O[8] = a; }
            __builtin_amdgcn_s_setprio(0);
            const float wi = vwi[irow], rt = vrow[irow];
#pragma unroll
            for (int nt = 0; nt < 9; ++nt) O[nt] = O[nt] * wi;
#pragma unroll
            for (int nt = 0; nt < 8; ++nt) { f32x4 a = (f32x4){0.f, 0.f, 0.f, 0.f}; bf16x8 kr[4];
#pragma unroll
                for (int s = 0; s < 4; ++s) kr[s] = ROWFRAG(IMG_K, 16 * nt, s);
                __builtin_amdgcn_sched_barrier(0);
#pragma unroll
                for (int s = 0; s < 4; ++s) a = MFMA16(kr[s], qf[s], a);
                const f32x4 ct = *(const LAS f32x4*)(vcol + 16 * nt + 4 * fg); float p[4];
#pragma unroll
                for (int e = 0; e < 4; ++e) { const int j = 16 * nt + 4 * fg + e;
                    const bool keep = dir ? (is_m ? (j >= irow) : (j > irow)) : (j <= irow);
                    const float ex = __builtin_amdgcn_exp2f(rt + ct[e]); p[e] = keep ? a[e] * ex : 0.f; }
                u32x2 pv; pv.x = cvt_pk_bf16(p[0], p[1]); pv.y = cvt_pk_bf16(p[2], p[3]);
                { LAUNDER_X16 *(LAS u32x2*)(lds + IMG_Q + CWA(nt)) = pv; } __builtin_amdgcn_sched_barrier(0); }
            bf16x8 pf[4];
#pragma unroll
            for (int s = 0; s < 4; ++s) pf[s] = ROWFRAG(IMG_Q, 16 * w, s);
            bf16x8 kf[4], kraw[4];
#pragma unroll
            for (int ks = 0; ks < 4; ++ks) kraw[ks] = trfrag_(lds, IMG_K + 256u * (32u * ks) + ktb0, IMG_K + 256u * (32u * ks + 4u) + ktb1);
            __builtin_amdgcn_sched_barrier(0);
#pragma unroll
            for (int ks = 0; ks < 4; ++ks) { const bf16x8 raw = kraw[ks];
                const f32x4 k0 = *(const LAS f32x4*)(vkw + 32 * ks + 8 * fg), k1 = *(const LAS f32x4*)(vkw + 32 * ks + 8 * fg + 4);
                float f[8];
#pragma unroll
                for (int e = 0; e < 8; ++e) f[e] = __uint_as_float(((unsigned)(unsigned short)raw[e]) << 16) * (e < 4 ? k0[e] : k1[e - 4]);
                u32x4 pk; pk.x = cvt_pk_bf16(f[0], f[1]); pk.y = cvt_pk_bf16(f[2], f[3]); pk.z = cvt_pk_bf16(f[4], f[5]); pk.w = cvt_pk_bf16(f[6], f[7]);
                kf[ks] = __builtin_bit_cast(bf16x8, pk); }
            __builtin_amdgcn_s_setprio(1);
#pragma unroll
            for (int nt = 0; nt < 8; ++nt) { LAUNDER_L16
                bf16x8 vf[4];
#pragma unroll
                for (int ks = 0; ks < 4; ++ks) vf[ks] = TRFRAG(IMG_V, nt, ks);
                __builtin_amdgcn_sched_barrier(0);
                f32x4 a = Cacc[nt] * decay;
#pragma unroll
                for (int ks = 0; ks < 4; ++ks) { O[nt] = MFMA16(vf[ks], pf[ks], O[nt]); a = MFMA16(vf[ks], kf[ks], a); }
                Cacc[nt] = a; }
            if (is_m) { f32x4 a = Cacc[8] * decay;
#pragma unroll
                for (int ks = 0; ks < 4; ++ks) { const bf16x8 vx = TRFRAGX(IMG_VX, ks); O[8] = MFMA16(vx, pf[ks], O[8]); a = MFMA16(vx, kf[ks], a); }
                Cacc[8] = a; }
            __builtin_amdgcn_s_setprio(0);
            float hs = 1.0f;
            if (is_m) { const float den = __shfl(O[8][0], fr); hs = 1.0f / fmaxf(fabsf(den), vemt[irow]); }
            bf16_t* mrow = mixed + (size_t)(tok + irow) * DM + mcol + 4 * fg;
            if (!final_pass) {
#pragma unroll
                for (int nt = 0; nt < 8; ++nt) { u32x2 v; v.x = cvt_pk_bf16(O[nt][0] * hs, O[nt][1] * hs); v.y = cvt_pk_bf16(O[nt][2] * hs, O[nt][3] * hs); *(u32x2*)(mrow + 16 * nt) = v; }
            } else {
                float sum = 0.f;
                const bf16_t* grow = proj + (size_t)(tok + irow) * NPROJ + gcol + 4 * fg;
                u32x2 hbv[8], gvv[8];
#pragma unroll
                for (int nt = 0; nt < 8; ++nt) { hbv[nt] = *(const u32x2*)(mrow + 16 * nt); gvv[nt] = *(const u32x2*)(grow + 16 * nt); }
                __builtin_amdgcn_sched_barrier(0);
#pragma unroll
                for (int nt = 0; nt < 8; ++nt) { const u32x2 hb = hbv[nt];
                    O[nt][0] = O[nt][0] * hs + bf_lo(hb.x); O[nt][1] = O[nt][1] * hs + bf_hi(hb.x); O[nt][2] = O[nt][2] * hs + bf_lo(hb.y); O[nt][3] = O[nt][3] * hs + bf_hi(hb.y);
                    sum += O[nt][0] + O[nt][1] + O[nt][2] + O[nt][3]; }
                sum += __shfl_xor(sum, 16); sum += __shfl_xor(sum, 32);
                const float mu = sum * (1.0f / 128.0f); float sq = 0.f;
#pragma unroll
                for (int nt = 0; nt < 8; ++nt)
#pragma unroll
                    for (int e = 0; e < 4; ++e) { const float d = O[nt][e] - mu; sq += d * d; }
                sq += __shfl_xor(sq, 16); sq += __shfl_xor(sq, 32);
                const float rs = rsqrtf(sq * (1.0f / 128.0f) + 1e-5f);
#pragma unroll
                for (int nt = 0; nt < 8; ++nt) { const u32x2 gv = gvv[nt]; const f32x4 gw = *(const f32x4*)(gnw + 16 * nt + 4 * fg);
                    float gt[4] = {bf_lo(gv.x), bf_hi(gv.x), bf_lo(gv.y), bf_hi(gv.y)}; float y[4];
#pragma unroll
                    for (int e = 0; e < 4; ++e) { const float sg = sigmoidf_(gt[e]); const float gate = is_m ? sg : gt[e] * sg; y[e] = (O[nt][e] - mu) * rs * gw[e] * gate; }
                    u32x2 v; v.x = cvt_pk_bf16(y[0], y[1]); v.y = cvt_pk_bf16(y[2], y[3]); *(u32x2*)(mrow + 16 * nt) = v; }
            }
        }
        if (state_only) {
            bf16x8 kf[4], kraw[4];
#pragma unroll
            for (int ks = 0; ks < 4; ++ks) kraw[ks] = trfrag_(lds, IMG_K + 256u * (32u * ks) + ktb0, IMG_K + 256u * (32u * ks + 4u) + ktb1);
            __builtin_amdgcn_sched_barrier(0);
#pragma unroll
            for (int ks = 0; ks < 4; ++ks) { const bf16x8 raw = kraw[ks];
                const f32x4 k0 = *(const LAS f32x4*)(vkw + 32 * ks + 8 * fg), k1 = *(const LAS f32x4*)(vkw + 32 * ks + 8 * fg + 4);
                float f[8];
#pragma unroll
                for (int e = 0; e < 8; ++e) f[e] = __uint_as_float(((unsigned)(unsigned short)raw[e]) << 16) * (e < 4 ? k0[e] : k1[e - 4]);
                u32x4 pk; pk.x = cvt_pk_bf16(f[0], f[1]); pk.y = cvt_pk_bf16(f[2], f[3]); pk.z = cvt_pk_bf16(f[4], f[5]); pk.w = cvt_pk_bf16(f[6], f[7]);
                kf[ks] = __builtin_bit_cast(bf16x8, pk); }
#pragma unroll
            for (int nt = 0; nt < 8; ++nt) { f32x4 a = Cacc[nt] * decay; LAUNDER_L16
                bf16x8 vf[4];
#pragma unroll
                for (int ks = 0; ks < 4; ++ks) vf[ks] = TRFRAG(IMG_V, nt, ks);
                __builtin_amdgcn_sched_barrier(0);
#pragma unroll
                for (int ks = 0; ks < 4; ++ks) a = MFMA16(vf[ks], kf[ks], a);
                Cacc[nt] = a; }
            if (is_m) { f32x4 a = Cacc[8] * decay;
#pragma unroll
                for (int ks = 0; ks < 4; ++ks) a = MFMA16(TRFRAGX(IMG_VX, ks), kf[ks], a);
                Cacc[8] = a; }
        }
        if (!state_only) {
            __syncthreads();
#pragma unroll
            for (int nt = 0; nt < 8; ++nt) { u32x2 v; v.x = cvt_pk_bf16(Cacc[nt][0], Cacc[nt][1]); v.y = cvt_pk_bf16(Cacc[nt][2], Cacc[nt][3]);
                { LAUNDER_X16 *(LAS u32x2*)(lds + IMG_C + CWA(nt)) = v; } }
            { u32x2 v; v.x = cvt_pk_bf16(Cacc[8][0], Cacc[8][1]); v.y = cvt_pk_bf16(Cacc[8][2], Cacc[8][3]); *(LAS u32x2*)(lds + IMG_CX + 32 * (16 * w + fr) + 8 * fg) = v; }
        }
    }
}

__device__ __forceinline__ int tot_slot(int sg, int hd, int dir) {
    if (sg < 16) { const int seq = sg >> 3, s = sg & 7; return ((seq * 8 + hd) * 2 + dir) * 7 + (dir ? s - 1 : s); }
    const int seq = (sg - 16) >> 1; return 224 + (seq * 8 + hd) * 2 + dir;
}
__device__ __forceinline__ float head_lgam(const Params& P, int hd, int dir) { return hd < 4 ? logsigmoidf_(P.in[9][dir * 4 + hd]) : 0.f; }

__device__ void phase_mix1(const Params& P, LAS unsigned char* lds, const int G, const int bid) {
    unsigned char* dob = (unsigned char*)P.out; float* tot = (float*)(dob + DO_TOT); float* tots = (float*)(dob + DO_TOTS);
    for (int it = bid; it < NSLOT; it += G) {
        int sg, hd, dir;
        if (it < 224) { const int k = it % 7, r = it / 7; dir = r & 1; hd = (r >> 1) & 7; const int seq = r >> 4; sg = seq * 8 + (dir ? k + 1 : k); }
        else { const int r = it - 224; dir = r & 1; hd = (r >> 1) & 7; const int seq = r >> 4; sg = 16 + seq * 2 + (dir ? 1 : 0); }
        const int seqlen = sg < 16 ? 8192 : 2048; const int pos0 = (sg < 16 ? (sg & 7) : ((sg - 16) & 1)) * 1024;
        f32x4 C[9];
#pragma unroll
        for (int i = 0; i < 9; ++i) C[i] = (f32x4){0.f, 0.f, 0.f, 0.f};
        float m = 0.f, as = 0.f;
        mix_sweep(P, lds, sg * 1024, pos0, seqlen, hd, dir, true, false, C, m, as, head_lgam(P, hd, dir));
        float* tp = tot + ((size_t)it * 512 + threadIdx.x) * 36;
#pragma unroll
        for (int i = 0; i < 9; ++i) *(f32x4*)(tp + 4 * i) = C[i];
        if (threadIdx.x == 0) { tots[it * 2] = m; tots[it * 2 + 1] = as; }
    }
    { const int nfree = G - (NSLOT - G > 0 ? NSLOT - G : 0); const int first = G - nfree;
      __syncthreads();
      if (nfree > 0 && bid >= first) convert_rest(P, (LAS float*)lds, bid - first, nfree);
      else if (nfree <= 0) convert_rest(P, (LAS float*)lds, bid, G); }
}
__device__ void phase_mix2(const Params& P, LAS unsigned char* lds, const int G, const int bid) {
    unsigned char* dob = (unsigned char*)P.out; const float* tot = (const float*)(dob + DO_TOT); const float* tots = (const float*)(dob + DO_TOTS);
    for (int it = bid; it < 256; it += G) {
        const int sg = it >> 3, hd = it & 7;
        const int seqlen = sg < 16 ? 8192 : 2048; const int s = sg < 16 ? (sg & 7) : ((sg - 16) & 1), nseg = sg < 16 ? 8 : 2; const int sg0 = sg - s;
        for (int pass = 0; pass < 2; ++pass) { const int dir = pass ? 0 : 1;
            f32x4 C[9];
#pragma unroll
            for (int i = 0; i < 9; ++i) C[i] = (f32x4){0.f, 0.f, 0.f, 0.f};
            float m = 0.f, as = 0.f;
            const int nfold = dir ? nseg - 1 - s : s;
            for (int f = 0; f < nfold; ++f) { const int sp = dir ? nseg - 1 - f : f; const int slot = tot_slot(sg0 + sp, hd, dir);
                const float mseg = tots[slot * 2], aseg = tots[slot * 2 + 1];
                const float mnew = fmaxf(aseg + m, mseg), d0 = __expf(aseg + m - mnew), d1 = __expf(mseg - mnew);
                const float* tp = tot + ((size_t)slot * 512 + threadIdx.x) * 36;
#pragma unroll
                for (int i = 0; i < 9; ++i) C[i] = C[i] * d0 + *(const f32x4*)(tp + 4 * i) * d1;
                m = mnew; }
            mix_sweep(P, lds, sg * 1024, s * 1024, seqlen, hd, dir, false, pass == 1, C, m, as, head_lgam(P, hd, dir));
        }
    }
}

#define XB_TMO      128
#define XB_XCNT(j)  (256  + 64 * (j))
#define XB_XSUB(j)  (1280 + 64 * (j))
#define XB_XGEN(j)  (2304 + 64 * (j))
#define XB_TOP      3328
#define XB_TOPGEN   3392
#define XCD_BAR_WORDS 3456
#define XB_SPIN_CAP (1u << 18)

__device__ __forceinline__ unsigned xb_ld(unsigned* p)              { return __hip_atomic_load(p, __ATOMIC_RELAXED, __HIP_MEMORY_SCOPE_AGENT); }
__device__ __forceinline__ unsigned xb_add(unsigned* p, unsigned v) { return __hip_atomic_fetch_add(p, v, __ATOMIC_RELAXED, __HIP_MEMORY_SCOPE_AGENT); }
__device__ __forceinline__ unsigned xb_xcc_id() { return (unsigned)__builtin_amdgcn_s_getreg((3 << 11) | 20) & 0xFu; }
#define XB_SPIN(cond, bar) do { unsigned _sp = 0; while (cond) { __builtin_amdgcn_s_sleep(1); \
    if ((++_sp & 255u) == 0u) { if (xb_ld(&(bar)[XB_TMO])) break; if (_sp > XB_SPIN_CAP) { atomicAdd(&(bar)[XB_TMO], 1u); break; } } } } while (0)

struct XcdBarrier {
    unsigned* bar; unsigned x;
    volatile LAS unsigned* st;
};

__device__ __forceinline__ XcdBarrier xcd_barrier_post(unsigned* bar, volatile LAS unsigned* st) {
    XcdBarrier b; b.bar = bar; b.x = xb_xcc_id(); b.st = st;
    if (threadIdx.x == 0) (void)xb_add(&bar[XB_XCNT(b.x)], 1u);
    return b;
}
__device__ __forceinline__ void xcd_barrier_complete(unsigned* bar, unsigned x, unsigned& nloc, unsigned& nx) {
    const unsigned G = gridDim.x * gridDim.y * gridDim.z;
    unsigned sum, cnt, mine, sp = 0u;
    for (;;) {
        sum = 0u; cnt = 0u; mine = 0u;
#pragma unroll
        for (unsigned j = 0; j < 16; ++j) { const unsigned c = xb_ld(&bar[XB_XCNT(j)]); sum += c; cnt += (c > 0u) ? 1u : 0u; mine = (j == x) ? c : mine; }
        if (sum == G) break;
        __builtin_amdgcn_s_sleep(1);
        if ((++sp & 255u) == 0u) { if (xb_ld(&bar[XB_TMO])) break; if (sp > XB_SPIN_CAP) { atomicAdd(&bar[XB_TMO], 1u); break; } }
    }
    nloc = mine > 0u ? mine : 1u; nx = cnt > 0u ? cnt : 1u;
}

__device__ __forceinline__ void xcd_barrier(const XcdBarrier& b) {
    asm volatile("s_waitcnt vmcnt(0)" ::: "memory");
    __syncthreads();
    if (threadIdx.x == 0) {
        unsigned* bar = b.bar;
        __builtin_amdgcn_s_waitcnt(0);
        unsigned nloc = b.st[0], nx = b.st[1];
        if (nloc == 0u) { xcd_barrier_complete(bar, b.x, nloc, nx); b.st[0] = nloc; b.st[1] = nx; }
        const unsigned old = xb_add(&bar[XB_XSUB(b.x)], 1u);
        const unsigned gen = old / nloc;
        if (old + 1u == (gen + 1u) * nloc) {
            __builtin_amdgcn_fence(__ATOMIC_RELEASE, "agent");
            asm volatile("s_waitcnt vmcnt(0)" ::: "memory");
            const unsigned og = xb_add(&bar[XB_TOP], 1u);
            const unsigned tg = og / nx;
            if (og + 1u == (tg + 1u) * nx) xb_add(&bar[XB_TOPGEN], 1u);
            else XB_SPIN(xb_ld(&bar[XB_TOPGEN]) == tg, bar);
            __builtin_amdgcn_fence(__ATOMIC_ACQUIRE, "agent");
            xb_add(&bar[XB_XGEN(b.x)], 1u);
            asm volatile("s_waitcnt vmcnt(0)" ::: "memory");
        } else {
            XB_SPIN(xb_ld(&bar[XB_XGEN(b.x)]) == gen, bar);
            __builtin_amdgcn_fence(__ATOMIC_ACQUIRE, "agent");
            asm volatile("s_waitcnt vmcnt(0)" ::: "memory");
        }
    }
    __syncthreads();
}


__global__ void __launch_bounds__(512, 2) mega(Params P0) {
    extern __shared__ __attribute__((aligned(16))) unsigned char shm[];
    LAS unsigned char* lds = (LAS unsigned char*)shm;
    cg::grid_group grid = cg::this_grid();
    volatile LAS unsigned* xst = (volatile LAS unsigned*)(lds + 155632);
    if (threadIdx.x == 0) { xst[0] = 0u; xst[1] = 0u; }
    __syncthreads();
    XcdBarrier xb = xcd_barrier_post((unsigned*)((unsigned char*)P0.out + DO_BAR), xst);
    typedef const Params __attribute__((address_space(4))) * KArgP;
    const int ph_lo = P0.ph_lo, ph_hi = P0.ph_hi;
    for (int ph = ph_lo; ph <= ph_hi; ++ph) {
        int tid = threadIdx.x; asm volatile("" : "+v"(tid));
        int G = gridDim.x, bid = blockIdx.x; asm volatile("" : "+s"(G)); asm volatile("" : "+s"(bid));
        KArgP kp = (KArgP)__builtin_amdgcn_kernarg_segment_ptr(); asm volatile("" : "+s"(kp));
        Params P;
#pragma unroll
        for (int i = 0; i < 24; ++i) P.in[i] = kp->in[i];
        P.out = kp->out; P.ws = kp->ws; P.ph_lo = 0; P.ph_hi = 0;
        unsigned char* dob = (unsigned char*)P.out; unsigned char* ws = P.ws;
        if (ph == 0) phase0(P, lds, G, bid);
        else if (ph == 1) { pg8::Gemm g{(const bf16_t*)(dob + DO_ABF), (const bf16_t*)(dob + DO_W1T), NTOK, NPROJ, DM}; pg8::StaticOrder S; S.init(NTOK, NPROJ, G, bid);
            EpiProj E{(bf16_t*)(ws + WS_PROJ), (const f32x2*)(dob + DO_ROPE), (bf16_t*)(dob + DO_HQ), P.in[6], P.in[7]}; pg8::gemm_phase(lds, g, S, E); }
        else if (ph == 2) phase_conv(P, G, bid);
        else if (ph == 3) phase_mix1(P, lds, G, bid);
        else if (ph == 4) phase_mix2(P, lds, G, bid);
        else if (ph == 5) {
            { float* r2 = (float*)(ws + WS_RSS2); for (int i = bid * 512 + tid; i < 2 * NTOK; i += G * 512) r2[i] = 0.f;
              if (bid == 0 && tid == 0) __hip_atomic_store((unsigned*)(ws + WS_BAR), 0u, __ATOMIC_RELAXED, __HIP_MEMORY_SCOPE_AGENT); }
            pg8::Gemm g{(const bf16_t*)(dob + DO_MIXED), (const bf16_t*)(dob + DO_WOT), NTOK, DM, DM}; pg8::StaticOrder S; S.init(NTOK, DM, G, bid);
            EpiG2 E{P.in[0], P.in[1], (float*)(ws + WS_H1), (bf16_t*)(ws + WS_H1B), (float*)(dob + DO_RSS1)}; pg8::gemm_phase(lds, g, S, E); }
        else if (ph >= 6 && ph <= 9) { const int half = (ph - 6) >> 1, sub = (ph - 6) & 1;
            const bf16_t* hb = (const bf16_t*)(ws + WS_H1B) + (size_t)half * HALF_TOK * DM;
            if (sub == 0) { pg8::Gemm g{hb, (const bf16_t*)(dob + DO_WGT), HALF_TOK, 2 * DFF, DM}; pg8::StaticOrder S; S.init(HALF_TOK, 2 * DFF, G, bid);
                EpiF12 E{(bf16_t*)(dob + DO_G), (bf16_t*)(dob + DO_GR), (bf16_t*)(dob + DO_UP), (const float*)(dob + DO_RSS1), P.in[16], P.in[17], half}; pg8::gemm_phase(lds, g, S, E);
                if (half == 1) {
                    const int nun = (HALF_TOK / 256) * (2 * DFF / 256), rem = nun % G; const int nfree = rem ? G - rem : 0, sub = rem ? bid - rem : -1;
                    if (sub >= 0) { asm volatile("s_waitcnt vmcnt(0)" ::: "memory"); __syncthreads();
                        pg8::Gemm g2{(const bf16_t*)(ws + WS_PBF), (const bf16_t*)(ws + WS_WPP), NTOK, DM, PLE}; pg8::StaticOrder S2; S2.init(NTOK, DM, nfree, sub); S2.hi = 256;
                        EpiPP E2{(bf16_t*)(ws + WS_PPT), (bf16_t*)dob}; pg8::gemm_phase(lds, g2, S2, E2); } }
                if (half == 0) {
                    const int nun = (HALF_TOK / 256) * (2 * DFF / 256), rem = nun % G; const int nfree = rem ? G - rem : G, sub = rem ? bid - rem : bid;
                    if (sub >= 0) { bf16_t* pbf = (bf16_t*)(ws + WS_PBF); int tid = threadIdx.x; asm volatile("" : "+v"(tid));
                        for (int i = sub * 512 + tid; i < NTOK * PLE / 4; i += nfree * 512) { const int row = i >> 6, c4 = i & 63; const f32x4 v = *(const f32x4*)(prow(P, row) + 4 * c4);
                            u32x2 w; w.x = cvt_pk_bf16(v[0], v[1]); w.y = cvt_pk_bf16(v[2], v[3]); *(u32x2*)(pbf + (size_t)row * PLE + 4 * c4) = w; }
                        LAS float* tile = (LAS float*)lds;
                        for (int t = sub; t < 128 + 32; t += nfree) {
                            if (t < 128) { const int kt = t & 15, ntl = t >> 4; wt_tile(P.in[21], DM, kt * 64, ntl * 128, (bf16_t*)(ws + WS_WPG), DM, P.in[20], 1.0f, tile); }
                            else { const int u2 = t - 128, kt = u2 & 3, ntl = u2 >> 2; wt_tile(P.in[19], DM, kt * 64, ntl * 128, (bf16_t*)(ws + WS_WPP), PLE, nullptr, 1.0f, tile); } } } } }
            else { pg8::Gemm g{(const bf16_t*)(dob + DO_G), (const bf16_t*)(dob + DO_WDT), HALF_TOK, DM, DFF}; pg8::StaticOrder S; S.init(HALF_TOK, DM, G, bid);
                { pg8::Unit uu; int lastpm = -1; for (int i = 0; S.next(i, uu); ++i) if (uu.pm != lastpm) { ffn_fix((bf16_t*)(dob + DO_G), (const bf16_t*)(dob + DO_GR), (const bf16_t*)(dob + DO_UP), P.in[16], P.in[17], uu.pm, half); lastpm = uu.pm; } }
                EpiF3 E{(float*)(ws + WS_H1), (bf16_t*)(ws + WS_H1B), (float*)(ws + WS_RSS2), half}; pg8::gemm_phase(lds, g, S, E); } }
        else if (ph == 10) {
            const bool pre = (((HALF_TOK / 256) * (2 * DFF / 256)) % G) != 0;
            bf16_t* T0 = pre ? (bf16_t*)(ws + WS_PPT) : (bf16_t*)dob; bf16_t* T1 = pre ? (bf16_t*)dob : (bf16_t*)(dob + 32 * MiB);
            { pg8::Gemm g{(const bf16_t*)(ws + WS_PBF), (const bf16_t*)(ws + WS_WPP), NTOK, DM, PLE}; pg8::StaticOrder S; S.init(NTOK, DM, G, bid); if (pre) S.lo = 256;
              EpiPP E{T0, T1}; pg8::gemm_phase(lds, g, S, E); }
            asm volatile("s_waitcnt vmcnt(0)" ::: "memory"); __syncthreads();
            { pg8::Gemm g{(const bf16_t*)(ws + WS_H1B), (const bf16_t*)(ws + WS_WPG), NTOK, DM, DM}; pg8::StaticOrder S; S.init(NTOK, DM, G, bid);
              EpiPG E{T0, T1, (float*)(ws + WS_H1), (const float*)(ws + WS_RSS2), P.in[22], (float*)(ws + WS_RSS3)}; pg8::gemm_phase(lds, g, S, E); } }
        else if (ph == 11) { const float* r3 = (const float*)(ws + WS_RSS3); const float* fw = P.in[23]; const f32x4* h3 = (const f32x4*)(ws + WS_H1);
            const int nchunk = NTOK * DM / 4 / 1024; const int wv = bid * 8 + (tid >> 6), lane = tid & 63;
            for (int ck = wv; ck < nchunk; ck += G * 8) { f32x4 v[16];
#pragma unroll
                for (int j = 0; j < 16; ++j) v[j] = __builtin_nontemporal_load(h3 + (ck * 16 + j) * 64 + lane);
#pragma unroll
                for (int j = 0; j < 16; ++j) { const int i = (ck * 16 + j) * 64 + lane; const int row = i >> 8, c4 = i & 255; const float rstd = rsqrtf(r3[row] * (1.0f / DM) + 1e-6f);
                    __builtin_nontemporal_store(v[j] * rstd * *(const f32x4*)(fw + 4 * c4), (f32x4*)P.out + i); } } }
        if (ph < ph_hi) {
            if (ph_lo < 0) grid.sync();
            xcd_barrier(xb);
        }
    }
}

extern "C" void kernel_launch(void* const* d_in, const int* in_sizes, int n_in, void* d_out, int out_size, void* d_ws, size_t ws_size, hipStream_t stream) {
    static int grid_blocks = 0;
    if (!grid_blocks) {
        int dev = 0, cus = 0, per_cu = 0;
        hipGetDevice(&dev);
        hipDeviceGetAttribute(&cus, hipDeviceAttributeMultiprocessorCount, dev);
        if (hipFuncSetAttribute((const void*)mega, hipFuncAttributeMaxDynamicSharedMemorySize, LDS_BYTES) != hipSuccess) { fprintf(stderr, "hipFuncSetAttribute failed\n"); }
        hipOccupancyMaxActiveBlocksPerMultiprocessor(&per_cu, (const void*)mega, 512, LDS_BYTES);
        if (per_cu < 1) per_cu = 1;
        grid_blocks = cus * 1;
        (void)hipGetLastError();
    }
    if (n_in < 24 || ws_size < 248 * MiB) { fprintf(stderr, "kernel_launch: unexpected inputs / workspace\n"); return; }
    Params p{};
    for (int i = 0; i < 24; ++i) p.in[i] = (const float*)d_in[i];
    p.out = (float*)d_out; p.ws = (unsigned char*)d_ws; p.ph_lo = 0; p.ph_hi = 11;
    if (hipMemsetAsync((char*)d_out + DO_BAR, 0, XCD_BAR_WORDS * 4, stream) != hipSuccess) { fprintf(stderr, "memset failed\n"); return; }
    void* args[] = {&p};
    hipError_t e = hipLaunchCooperativeKernel((const void*)mega, dim3(grid_blocks), dim3(512), args, LDS_BYTES, stream);
    if (e != hipSuccess) fprintf(stderr, "cooperative launch failed: %s (grid %d)\n", hipGetErrorString(e), grid_blocks);
}
```
